# Optimizing an MI355X kernel written in HIP

```python
import jax, jax.numpy as jnp
from jax import lax
import numpy as np

D_MODEL = 1024
BATCH = 16
SEQ = 2048
DEPTH = 1

PLE_DIM = 256
MIX_WIDTH = D_MODEL
NORM_EPS = 1e-6
D_FF = 4 * D_MODEL

GLA_WIDTH = MIX_WIDTH // 2
GLA_HEADS = 4
GLA_DV = GLA_WIDTH // GLA_HEADS
GLA_DK = GLA_DV // 2
GLA_KEY_WIDTH = GLA_HEADS * GLA_DK
GLA_GATE_RANK = 16
GLA_GATE_NORMALIZER = 16.0
GLA_CONV = 4
GLA_CHUNK = 64
GLA_COLS = 2 * GLA_KEY_WIDTH + 2 * GLA_WIDTH + GLA_GATE_RANK
GLA_SPLITS = (GLA_KEY_WIDTH, 2 * GLA_KEY_WIDTH, 2 * GLA_KEY_WIDTH + GLA_WIDTH, 2 * GLA_KEY_WIDTH + 2 * GLA_WIDTH)

RWKV_WIDTH = MIX_WIDTH - GLA_WIDTH
RWKV_HEAD = 64
RWKV_HEADS = RWKV_WIDTH // RWKV_HEAD
RWKV_DECAY_RANK = 32
RWKV_AAA_RANK = 32
RWKV_GATE_RANK = 96
RWKV_GN_EPS = 64e-5
RWKV_COLS = 3 * RWKV_WIDTH + RWKV_DECAY_RANK + RWKV_AAA_RANK + RWKV_GATE_RANK
RWKV_SPLITS = (RWKV_WIDTH, 2 * RWKV_WIDTH, 3 * RWKV_WIDTH, 3 * RWKV_WIDTH + RWKV_DECAY_RANK, 3 * RWKV_WIDTH + RWKV_DECAY_RANK + RWKV_AAA_RANK)

D_IN = GLA_COLS + RWKV_COLS

kernel_name = "hymba_gla_rwkv7_hybrid_block"


def _rmsnorm(x, g):
    xf = x.astype(jnp.float32)
    y = xf * lax.rsqrt(jnp.mean(xf * xf, axis=-1, keepdims=True) + NORM_EPS)
    return (y * g.astype(jnp.float32)).astype(x.dtype)


def _causal_dwconv(x, w):
    k = w.shape[0]
    return lax.conv_general_dilated(
        x, w[:, None, :].astype(x.dtype), window_strides=(1,), padding=[(k - 1, 0)],
        dimension_numbers=('NWC', 'WIO', 'NWC'), feature_group_count=x.shape[-1])


def _token_shift(y, mu):
    y_prev = jnp.pad(y, ((0, 0), (1, 0), (0, 0)))[:, :-1]
    return y + mu * (y_prev - y)


def _gla_mixer(z, conv_w, gk_w, gk_b, norm_g):
    B, S, _ = z.shape
    f32 = jnp.float32
    q, k, v, g, gk_low = jnp.split(z, GLA_SPLITS, axis=-1)
    qkv = jax.nn.silu(_causal_dwconv(jnp.concatenate([q, k, v], axis=-1), conv_w))
    q, k, v = jnp.split(qkv, (GLA_KEY_WIDTH, 2 * GLA_KEY_WIDTH), axis=-1)
    gk = jax.nn.log_sigmoid((gk_low @ gk_w + gk_b).astype(f32)) / GLA_GATE_NORMALIZER
    n_chunks = S // GLA_CHUNK

    def chunks(t, d):
        t = t.astype(f32).reshape(B, n_chunks, GLA_CHUNK, GLA_HEADS, d)
        return jnp.transpose(t, (1, 0, 3, 2, 4))

    qc = chunks(q, GLA_DK) * (GLA_DK ** -0.5)
    kc = chunks(k, GLA_DK)
    vc = chunks(v, GLA_DV)
    gc = chunks(gk, GLA_DK)
    causal = jnp.tril(jnp.ones((GLA_CHUNK, GLA_CHUNK), dtype=bool))

    def step(state, inp):
        qb, kb, vb, gb = inp
        b = jnp.cumsum(gb, axis=2)
        diff = b[:, :, :, None, :] - b[:, :, None, :, :]
        decay = jnp.exp(jnp.where(causal[:, :, None], diff, -jnp.inf))
        scores = jnp.einsum('bhid,bhjd,bhijd->bhij', qb, kb, decay)
        o = (jnp.einsum('bhij,bhje->bhie', scores, vb)
             + jnp.einsum('bhid,bhde->bhie', qb * jnp.exp(b), state))
        b_last = b[:, :, -1:, :]
        state = (jnp.exp(b_last[:, :, 0, :])[..., None] * state
                 + jnp.einsum('bhjd,bhje->bhde', kb * jnp.exp(b_last - b), vb))
        return state, o

    state0 = jnp.zeros((B, GLA_HEADS, GLA_DK, GLA_DV), f32)
    _, o = lax.scan(step, state0, (qc, kc, vc, gc))
    o = jnp.transpose(o, (1, 0, 3, 2, 4)).reshape(B, S, GLA_HEADS, GLA_DV)
    o = o * lax.rsqrt(jnp.mean(o * o, axis=-1, keepdims=True) + NORM_EPS) * norm_g.astype(f32)
    return o.reshape(B, S, GLA_WIDTH).astype(z.dtype) * jax.nn.silu(g)


def _rwkv7_mixer(z, mu, w0, w2, a0, a2, g2, k_k, k_a, r_k, gn_w, gn_b):
    B, S, _ = z.shape
    f32 = jnp.float32
    z = _token_shift(z, mu)
    r, k, v, w_low, a_low, g_low = jnp.split(z, RWKV_SPLITS, axis=-1)
    w_log = -jax.nn.softplus(-(w0 + jnp.tanh(w_low) @ w2).astype(f32)) - 0.5
    decay = jnp.exp(-jnp.exp(w_log))
    a = jax.nn.sigmoid((a0 + a_low @ a2).astype(f32))
    g = jax.nn.sigmoid(g_low) @ g2

    def heads(t):
        return t.astype(f32).reshape(B, S, RWKV_HEADS, RWKV_HEAD)

    kk = heads(k * k_k)
    kk = kk / jnp.maximum(jnp.sqrt(jnp.sum(kk * kk, axis=-1, keepdims=True)), 1e-12)
    kf = k.astype(f32) * (1.0 + (a - 1.0) * k_a.astype(f32))
    rh, kh, vh, wh, ah = heads(r), heads(kf), heads(v), heads(decay), heads(a)

    def tm(t):
        return jnp.moveaxis(t, 1, 0)

    def step(state, inp):
        r_t, w_t, k_t, v_t, a_t, b_t = inp
        sa = jnp.einsum('bhij,bhj->bhi', state, a_t)
        state = (state * w_t[:, :, None, :] + sa[..., None] * b_t[:, :, None, :]
                 + v_t[..., None] * k_t[:, :, None, :])
        return state, jnp.einsum('bhij,bhj->bhi', state, r_t)

    state0 = jnp.zeros((B, RWKV_HEADS, RWKV_HEAD, RWKV_HEAD), f32)
    _, y = lax.scan(step, state0, (tm(rh), tm(wh), tm(kh), tm(vh), tm(-kk), tm(kk * ah)))
    y = jnp.moveaxis(y, 0, 1)
    mean = jnp.mean(y, axis=-1, keepdims=True)
    var = jnp.mean(jnp.square(y - mean), axis=-1, keepdims=True)
    y = ((y - mean) * lax.rsqrt(var + RWKV_GN_EPS)).reshape(B, S, RWKV_WIDTH)
    y = y * gn_w.astype(f32) + gn_b.astype(f32)
    bonus = jnp.sum(rh * kh * r_k.astype(f32), axis=-1, keepdims=True) * vh
    y = y + bonus.reshape(B, S, RWKV_WIDTH)
    return y.astype(z.dtype) * g


def setup_inputs(seed: int = 0) -> dict:
    key = jax.random.key(seed)
    ks = jax.random.split(key, 32)
    nrm = lambda k, shape, scale: jax.random.normal(k, shape, jnp.float32) * scale
    gain = lambda k, shape: 1.0 + 0.02 * jax.random.normal(k, shape, jnp.float32)
    L = DEPTH
    return {
        "x": nrm(ks[0], (BATCH, SEQ, D_MODEL), 1.0),
        "p": nrm(ks[1], (DEPTH, BATCH, SEQ, PLE_DIM), 1.0),
        "ln_mix": gain(ks[2], (L, D_MODEL)),
        "w_in": nrm(ks[3], (L, D_MODEL, D_IN), D_MODEL ** -0.5),
        "gla_conv_w": nrm(ks[4], (L, GLA_CONV, 2 * GLA_KEY_WIDTH + GLA_WIDTH), GLA_CONV ** -0.5),
        "gla_gk_w": nrm(ks[5], (L, GLA_GATE_RANK, GLA_KEY_WIDTH), GLA_GATE_RANK ** -0.5),
        "gla_gk_b": nrm(ks[6], (L, GLA_KEY_WIDTH), 0.1),
        "gla_norm_g": gain(ks[7], (L, GLA_DV)),
        "rwkv_mu": jax.random.uniform(ks[8], (L, RWKV_COLS), jnp.float32, 0.0, 1.0),
        "rwkv_w0": jax.random.uniform(ks[9], (L, RWKV_WIDTH), jnp.float32, -6.0, -1.0),
        "rwkv_w2": nrm(ks[10], (L, RWKV_DECAY_RANK, RWKV_WIDTH), 0.5 * RWKV_DECAY_RANK ** -0.5),
        "rwkv_a0": nrm(ks[11], (L, RWKV_WIDTH), 0.1),
        "rwkv_a2": nrm(ks[12], (L, RWKV_AAA_RANK, RWKV_WIDTH), RWKV_AAA_RANK ** -0.5),
        "rwkv_g2": nrm(ks[13], (L, RWKV_GATE_RANK, RWKV_WIDTH), RWKV_GATE_RANK ** -0.5),
        "rwkv_k_k": 0.85 + nrm(ks[14], (L, RWKV_WIDTH), 0.02),
        "rwkv_k_a": gain(ks[15], (L, RWKV_WIDTH)),
        "rwkv_r_k": nrm(ks[16], (L, RWKV_HEADS, RWKV_HEAD), 0.1),
        "rwkv_gn_w": gain(ks[17], (L, RWKV_WIDTH)),
        "rwkv_gn_b": nrm(ks[18], (L, RWKV_WIDTH), 0.02),
        "w_out": nrm(ks[19], (L, MIX_WIDTH, D_MODEL), MIX_WIDTH ** -0.5),
        "ln_mlp": gain(ks[20], (L, D_MODEL)),
        "w_ff1": nrm(ks[21], (L, D_MODEL, D_FF), D_MODEL ** -0.5),
        "w_ff2": nrm(ks[22], (L, D_FF, D_MODEL), D_FF ** -0.5),
        "ln_ple": gain(ks[23], (L, D_MODEL)),
        "w_ple_gate": nrm(ks[24], (L, D_MODEL, D_MODEL), D_MODEL ** -0.5),
        "w_ple_proj": nrm(ks[25], (L, PLE_DIM, D_MODEL), PLE_DIM ** -0.5),
        "ln_final": gain(ks[26], (D_MODEL,)),
    }


def reference(x, p, ln_mix, w_in, gla_conv_w, gla_gk_w, gla_gk_b, gla_norm_g,
              rwkv_mu, rwkv_w0, rwkv_w2, rwkv_a0, rwkv_a2, rwkv_g2, rwkv_k_k, rwkv_k_a,
              rwkv_r_k, rwkv_gn_w, rwkv_gn_b, w_out, ln_mlp, w_ff1, w_ff2,
              ln_ple, w_ple_gate, w_ple_proj, ln_final):
    h = x
    for i in range(DEPTH):
        z = _rmsnorm(h, ln_mix[i]) @ w_in[i]
        z_gla, z_rwkv = z[..., :GLA_COLS], z[..., GLA_COLS:]
        o_gla = _gla_mixer(z_gla, gla_conv_w[i], gla_gk_w[i], gla_gk_b[i], gla_norm_g[i])
        o_rwkv = _rwkv7_mixer(z_rwkv, rwkv_mu[i], rwkv_w0[i], rwkv_w2[i], rwkv_a0[i],
                              rwkv_a2[i], rwkv_g2[i], rwkv_k_k[i], rwkv_k_a[i],
                              rwkv_r_k[i], rwkv_gn_w[i], rwkv_gn_b[i])
        h = h + jnp.concatenate([o_gla, o_rwkv], axis=-1) @ w_out[i]
        h = h + jnp.square(jax.nn.relu(_rmsnorm(h, ln_mlp[i]) @ w_ff1[i])) @ w_ff2[i]
        gate = jax.nn.sigmoid(_rmsnorm(h, ln_ple[i]) @ w_ple_gate[i])
        h = h + gate * (p[i] @ w_ple_proj[i])
    return _rmsnorm(h, ln_final)
```

```cpp
#include <hip/hip_runtime.h>
#include <hip/hip_cooperative_groups.h>
#include <cstdio>
#include <cstdint>
namespace cg = cooperative_groups;

#define GAS __attribute__((address_space(1)))
#define LAS __attribute__((address_space(3)))
typedef unsigned short bf16;
typedef unsigned v4u __attribute__((ext_vector_type(4)));
typedef unsigned v2u __attribute__((ext_vector_type(2)));

namespace pg8 {
#define PG8_LAS __attribute__((address_space(3)))
typedef unsigned short bf16_t;
typedef short bf16x8 __attribute__((ext_vector_type(8)));
typedef float f32x4 __attribute__((ext_vector_type(4)));
typedef unsigned u32x4 __attribute__((ext_vector_type(4)));
typedef unsigned u32x2 __attribute__((ext_vector_type(2)));
constexpr int BM = 256, BK = 64, HALF = 128, HTB = HALF * BK * 2  , STAGE_BYTES = 8 * HTB, NXCD = 8, WGM = 8;

__host__ __device__ __forceinline__ int lds_byte(int r, int c) { const int st = (r >> 4) * 2 + (c >> 5), rr = r & 15, cc = c & 31, ob = rr * 64 + cc * 2; return st * 1024 + (ob ^ (((ob >> 9) & 1) << 5)); }
__host__ __device__ __forceinline__ void stage_rc(int b, int& R, int& C) { const int st = b / 1024, sb = b % 1024, swz = sb ^ (((sb >> 9) & 1) << 5); R = (st >> 1) * 16 + swz / 64; C = (st & 1) * 32 + (swz % 64) / 2; }
__host__ __device__ __forceinline__ int perm32(int rho) { const int n = rho >> 4, i = rho & 15; return 8 * (i >> 2) + 4 * n + (i & 3); }

struct Unit { int pm, pn; };
struct Gemm { const bf16_t* A; const bf16_t* Bt; int M, N, K; };

struct StaticOrder {
    int nM, nN, nwg, G, c;
    __host__ __device__ void init(int M, int N, int G_, int c_) { nM = M / BM; nN = N / BM; nwg = nM * nN; G = G_; c = c_; }
    __host__ __device__ bool next(int i, Unit& u) const {
        const long L = (long)i * G + c; if (L >= nwg) return false;
        int wgid = (int)L; { const int q = nwg / NXCD, r = nwg % NXCD, xcd = wgid % NXCD, off = wgid / NXCD; wgid = (xcd < r ? xcd * (q + 1) : r * (q + 1) + (xcd - r) * q) + off; }
        const int nig = WGM * nN, gid = wgid / nig, fm = gid * WGM, gsz = (nM - fm) < WGM ? (nM - fm) : WGM;
        u.pm = fm + ((wgid % nig) % gsz); u.pn = (wgid % nig) / gsz; return true;
    }
    __device__ __forceinline__ void a_ready(const Unit&) const {}
    __device__ __forceinline__ void done(const Unit&) const {}
};

__device__ __forceinline__ unsigned cvt_pk_bf16(float lo, float hi) { unsigned r; asm volatile("v_cvt_pk_bf16_f32 %0, %1, %2" : "=v"(r) : "v"(lo), "v"(hi)); return r; }
__device__ __forceinline__ float bflo(unsigned w) { return __uint_as_float(w << 16); }
__device__ __forceinline__ float bfhi(unsigned w) { return __uint_as_float(w & 0xffff0000u); }
__device__ __forceinline__ void atomic_addf(float* p, float v) { __hip_atomic_fetch_add(p, v, __ATOMIC_RELAXED, __HIP_MEMORY_SCOPE_AGENT); }

struct EpiStoreBf16 {
    static constexpr bool PERM = true, AFTER_DRAIN = false;
    bf16_t* O; int ldc;
    __device__ __forceinline__ void operator()(const f32x4 (&acc)[2][2][4][2], const Unit& u, int wr, int wc, int fr, int fq) const {
        const int row0 = u.pm * BM + wr * 64 + fr, col0 = u.pn * BM + wc * 32 + 8 * fq;
#pragma unroll
        for (int ai = 0; ai < 2; ++ai)
#pragma unroll
            for (int m = 0; m < 4; ++m) { bf16_t* rowp = O + (size_t)(row0 + ai * HALF + m * 16) * ldc + col0;
#pragma unroll
                for (int bj = 0; bj < 2; ++bj) { const f32x4 v0 = acc[ai][bj][m][0], v1 = acc[ai][bj][m][1];
                    u32x4 w; w.x = cvt_pk_bf16(v0[0], v0[1]); w.y = cvt_pk_bf16(v0[2], v0[3]); w.z = cvt_pk_bf16(v1[0], v1[1]); w.w = cvt_pk_bf16(v1[2], v1[3]);
                    *(u32x4*)(rowp + bj * HALF) = w; } }
    }
};
struct EpiFF1 {
    static constexpr bool PERM = true, AFTER_DRAIN = false;
    bf16_t* O; int ldc; const float* ss; float eps;
    __device__ __forceinline__ void operator()(const f32x4 (&acc)[2][2][4][2], const Unit& u, int wr, int wc, int fr, int fq) const {
        const int row0 = u.pm * BM + wr * 64 + fr, col0 = u.pn * BM + wc * 32 + 8 * fq;
#pragma unroll
        for (int ai = 0; ai < 2; ++ai)
#pragma unroll
            for (int m = 0; m < 4; ++m) { const int row = row0 + ai * HALF + m * 16; bf16_t* rowp = O + (size_t)row * ldc + col0;
                const float rs = 1.0f / sqrtf(ss[row] * (1.0f / 1024.0f) + eps);
#pragma unroll
                for (int bj = 0; bj < 2; ++bj) { f32x4 v0 = acc[ai][bj][m][0] * rs, v1 = acc[ai][bj][m][1] * rs;
#pragma unroll
                    for (int j = 0; j < 4; ++j) { const float a = fmaxf(v0[j], 0.f), b = fmaxf(v1[j], 0.f); v0[j] = a * a; v1[j] = b * b; }
                    u32x4 w; w.x = cvt_pk_bf16(v0[0], v0[1]); w.y = cvt_pk_bf16(v0[2], v0[3]); w.z = cvt_pk_bf16(v1[0], v1[1]); w.w = cvt_pk_bf16(v1[2], v1[3]);
                    *(u32x4*)(rowp + bj * HALF) = w; } }
    }
};
struct EpiRes {
    static constexpr bool PERM = false, AFTER_DRAIN = false;
    const float* base; float* out; bf16_t* A; const float* gain; float* ss;
    __device__ __forceinline__ void operator()(const f32x4 (&acc)[2][2][4][2], const Unit& u, int wr, int wc, int fr, int fq) const {
        const int row0 = u.pm * BM + wr * 64 + fr, col0 = u.pn * BM + wc * 32 + 4 * fq;
        f32x4 gv[2][2];
#pragma unroll
        for (int bj = 0; bj < 2; ++bj)
#pragma unroll
            for (int n = 0; n < 2; ++n) gv[bj][n] = *(const f32x4*)(gain + col0 + bj * HALF + n * 16);
#pragma unroll
        for (int ai = 0; ai < 2; ++ai)
#pragma unroll
            for (int m = 0; m < 4; ++m) { const int row = row0 + ai * HALF + m * 16; const size_t off = (size_t)row * 1024 + col0; float q = 0.f;
#pragma unroll
                for (int bj = 0; bj < 2; ++bj)
#pragma unroll
                    for (int n = 0; n < 2; ++n) { const size_t o = off + bj * HALF + n * 16; const f32x4 bs = *(const f32x4*)(base + o); const f32x4 h = bs + acc[ai][bj][m][n];
                        *(f32x4*)(out + o) = h; q += (h[0] * h[0] + h[1] * h[1]) + (h[2] * h[2] + h[3] * h[3]);
                        const f32x4 a = h * gv[bj][n]; u32x2 w; w.x = cvt_pk_bf16(a[0], a[1]); w.y = cvt_pk_bf16(a[2], a[3]); *(u32x2*)(A + o) = w; }
                q += __shfl_xor(q, 16); q += __shfl_xor(q, 32);
                if (fq == 0) atomic_addf(ss + row, q);
                asm volatile("" ::: "memory"); }
    }
};
struct EpiGate {
    static constexpr bool PERM = false, AFTER_DRAIN = false;
    const float* h; const bf16_t* pp; float* out; const float* ss_in; float* ss_out; float eps;
    __device__ __forceinline__ void operator()(const f32x4 (&acc)[2][2][4][2], const Unit& u, int wr, int wc, int fr, int fq) const {
        const int row0 = u.pm * BM + wr * 64 + fr, col0 = u.pn * BM + wc * 32 + 4 * fq;
#pragma unroll
        for (int ai = 0; ai < 2; ++ai)
#pragma unroll
            for (int m = 0; m < 4; ++m) { const int row = row0 + ai * HALF + m * 16; const size_t off = (size_t)row * 1024 + col0; float q = 0.f;
                const float rs = 1.0f / sqrtf(ss_in[row] * (1.0f / 1024.0f) + eps);
#pragma unroll
                for (int bj = 0; bj < 2; ++bj)
#pragma unroll
                    for (int n = 0; n < 2; ++n) { const size_t o = off + bj * HALF + n * 16; const f32x4 hv = *(const f32x4*)(h + o); const u32x2 pw = *(const u32x2*)(pp + o);
                        const f32x4 g = acc[ai][bj][m][n] * rs; f32x4 r;
                        r[0] = hv[0] + bflo(pw.x) / (1.0f + __expf(-g[0])); r[1] = hv[1] + bfhi(pw.x) / (1.0f + __expf(-g[1]));
                        r[2] = hv[2] + bflo(pw.y) / (1.0f + __expf(-g[2])); r[3] = hv[3] + bfhi(pw.y) / (1.0f + __expf(-g[3]));
                        *(f32x4*)(out + o) = r; q += (r[0] * r[0] + r[1] * r[1]) + (r[2] * r[2] + r[3] * r[3]); }
                q += __shfl_xor(q, 16); q += __shfl_xor(q, 32);
                if (fq == 0) atomic_addf(ss_out + row, q);
                asm volatile("" ::: "memory"); }
    }
};

template <class Epi, class Sched, bool ALIGN_EPI = false, bool SP2 = false>
__device__ __forceinline__ void gemm_phase(PG8_LAS unsigned char* lds, const Gemm g, const Sched& S, const Epi& E) {
    const int tid = threadIdx.x, wid = __builtin_amdgcn_readfirstlane(tid >> 6), lane = tid & 63, wr = wid >> 2, wc = wid & 3, fr = lane & 15, fq = lane >> 4;
    const int K = g.K, nt = K / BK;
    unsigned voffA[2], voffB[2];
#pragma unroll
    for (int i = 0; i < 2; ++i) { int R, C; stage_rc(tid * 16 + i * 8192, R, C); const int Rb = Epi::PERM ? ((R & ~31) + perm32(R & 31)) : R;
        voffA[i] = (unsigned)(R * K + C) * 2u; voffB[i] = (unsigned)(Rb * K + C) * 2u; }
    const size_t kstep = (size_t)(BK * 2);
    const size_t hstep = (size_t)HALF * K * 2;
    const size_t tstep = 2 * hstep;
    const unsigned ldsw = (unsigned)wid * 1024u;
    const int aoff = lds_byte(wr * 64 + fr, fq * 8), boff = lds_byte(wc * 32 + fr, fq * 8);
#define PG8_SA(b, h) (((b) * 2 + (h)) * HTB)
#define PG8_SB(b, h) ((4 + (b) * 2 + (h)) * HTB)
#define PG8_STAGE(bufoff, gbase, voff) do { _Pragma("unroll") for (int _i = 0; _i < 2; ++_i) \
        __builtin_amdgcn_global_load_lds((const unsigned*)((const char*)(gbase) + (voff)[_i]), (PG8_LAS unsigned*)(lds + (bufoff) + ldsw + _i * 8192), 16, 0, 0); } while (0)
#define PG8_LDA(dst, b, h) do { _Pragma("unroll") for (int m = 0; m < 4; ++m) _Pragma("unroll") for (int k = 0; k < 2; ++k) dst[m][k] = *(const PG8_LAS bf16x8*)(lds + PG8_SA(b, h) + aoff + m * 2048 + k * 1024); } while (0)
#define PG8_LDB(dst, b, h) do { _Pragma("unroll") for (int n = 0; n < 2; ++n) _Pragma("unroll") for (int k = 0; k < 2; ++k) dst[n][k] = *(const PG8_LAS bf16x8*)(lds + PG8_SB(b, h) + boff + n * 2048 + k * 1024); } while (0)
#define PG8_MMA(ai, bj, At, Bt) do { __builtin_amdgcn_s_setprio(1); _Pragma("unroll") for (int m = 0; m < 4; ++m) _Pragma("unroll") for (int n = 0; n < 2; ++n) _Pragma("unroll") for (int k = 0; k < 2; ++k) \
        acc[ai][bj][m][n] = __builtin_amdgcn_mfma_f32_16x16x32_bf16(Bt[n][k], At[m][k], acc[ai][bj][m][n], 0, 0, 0); __builtin_amdgcn_s_setprio(0); } while (0)
#define PG8_WAIT_V(n) asm volatile("s_waitcnt vmcnt(" #n ")" ::: "memory")
#define PG8_WAIT_L(n) asm volatile("s_waitcnt lgkmcnt(" #n ")" ::: "memory")
#define PG8_BAR __builtin_amdgcn_s_barrier()
#define PG8_SCHED __builtin_amdgcn_sched_barrier(0)
    Unit cur, nxt; int ui = 0;
    if (!S.next(0, cur)) return;
    f32x4 acc[2][2][4][2];
#pragma unroll
    for (int a = 0; a < 2; ++a)
#pragma unroll
        for (int b = 0; b < 2; ++b)
#pragma unroll
            for (int m = 0; m < 4; ++m)
#pragma unroll
                for (int n = 0; n < 2; ++n) acc[a][b][m][n] = (f32x4){0.f, 0.f, 0.f, 0.f};
    bf16x8 At[4][2], B0[2][2], B1[2][2];
    const char* cA = (const char*)g.A + (size_t)cur.pm * tstep; const char* cB = (const char*)g.Bt + (size_t)cur.pn * tstep;
    S.a_ready(cur);
    if constexpr (SP2) {
        PG8_STAGE(PG8_SB(0, 0), cB, voffB); PG8_STAGE(PG8_SB(0, 1), cB + hstep, voffB); PG8_STAGE(PG8_SA(0, 0), cA, voffA); PG8_STAGE(PG8_SA(0, 1), cA + hstep, voffA);
        if (wr == 1) PG8_BAR;
        PG8_WAIT_V(2); PG8_BAR;
        PG8_STAGE(PG8_SB(1, 0), cB + kstep, voffB); PG8_STAGE(PG8_SA(1, 0), cA + kstep, voffA); PG8_STAGE(PG8_SB(1, 1), cB + hstep + kstep, voffB);
        PG8_WAIT_V(6); PG8_BAR;
    } else {
        PG8_STAGE(PG8_SB(0, 0), cB, voffB); PG8_STAGE(PG8_SA(0, 0), cA, voffA); PG8_STAGE(PG8_SB(0, 1), cB + hstep, voffB); PG8_STAGE(PG8_SA(0, 1), cA + hstep, voffA);
        if (wr == 1) PG8_BAR;
        PG8_WAIT_V(4); PG8_BAR;
        PG8_STAGE(PG8_SB(1, 0), cB + kstep, voffB); PG8_STAGE(PG8_SA(1, 0), cA + kstep, voffA); PG8_STAGE(PG8_SB(1, 1), cB + hstep + kstep, voffB);
        PG8_WAIT_V(6); PG8_BAR;
    }
    for (;;) {
        const bool has_next = S.next(ui + 1, nxt);
        const char* nA = has_next ? (const char*)g.A + (size_t)nxt.pm * tstep : cA; const char* nB = has_next ? (const char*)g.Bt + (size_t)nxt.pn * tstep : cB;
        for (int t = 0; t < nt; t += 2) {
            const bool last = (t == nt - 2);
            const char* a1 = cA + (size_t)(t + 1) * kstep;
            const char* a2 = last ? nA : cA + (size_t)(t + 2) * kstep; const char* b2 = last ? nB : cB + (size_t)(t + 2) * kstep;
            const char* a3 = a2 + kstep; const char* b3 = b2 + kstep;
            if (last && has_next) S.a_ready(nxt);
            if constexpr (SP2) {
            PG8_LDB(B0, 0, 0); PG8_LDB(B1, 0, 1); PG8_SCHED; PG8_LDA(At, 0, 0); PG8_STAGE(PG8_SA(1, 1), a1 + hstep, voffA);
            PG8_WAIT_V(8); PG8_WAIT_L(0); PG8_BAR; PG8_MMA(0, 0, At, B0); PG8_MMA(0, 1, At, B1); PG8_BAR; PG8_SCHED;
            PG8_LDA(At, 0, 1); PG8_STAGE(PG8_SB(0, 0), b2, voffB); PG8_STAGE(PG8_SB(0, 1), b2 + hstep, voffB); PG8_STAGE(PG8_SA(0, 0), a2, voffA);
            PG8_WAIT_V(8); PG8_WAIT_L(0); PG8_BAR; PG8_MMA(1, 0, At, B0); PG8_MMA(1, 1, At, B1); PG8_BAR; PG8_SCHED;
            PG8_LDB(B0, 1, 0); PG8_LDB(B1, 1, 1); PG8_SCHED; PG8_LDA(At, 1, 0); PG8_STAGE(PG8_SA(0, 1), a2 + hstep, voffA);
            PG8_WAIT_V(8); PG8_WAIT_L(0); PG8_BAR; PG8_MMA(0, 0, At, B0); PG8_MMA(0, 1, At, B1); PG8_BAR; PG8_SCHED;
            PG8_LDA(At, 1, 1); PG8_STAGE(PG8_SB(1, 0), b3, voffB); PG8_STAGE(PG8_SB(1, 1), b3 + hstep, voffB); PG8_STAGE(PG8_SA(1, 0), a3, voffA);
            PG8_WAIT_V(8); PG8_WAIT_L(0); PG8_BAR; PG8_MMA(1, 0, At, B0); PG8_MMA(1, 1, At, B1); PG8_BAR; PG8_SCHED;
            } else {
            PG8_LDB(B0, 0, 0); PG8_SCHED; PG8_LDA(At, 0, 0); PG8_STAGE(PG8_SA(1, 1), a1 + hstep, voffA);
            PG8_WAIT_L(8); PG8_BAR; PG8_WAIT_L(0); PG8_MMA(0, 0, At, B0); PG8_BAR; PG8_SCHED;
            PG8_LDB(B1, 0, 1); PG8_STAGE(PG8_SB(0, 0), b2, voffB);
            PG8_BAR; PG8_WAIT_L(0); PG8_MMA(0, 1, At, B1); PG8_BAR;
            PG8_LDA(At, 0, 1); PG8_STAGE(PG8_SA(0, 0), a2, voffA);
            PG8_BAR; PG8_WAIT_L(0); PG8_MMA(1, 0, At, B0); PG8_BAR; PG8_SCHED;
            PG8_STAGE(PG8_SB(0, 1), b2 + hstep, voffB);
            PG8_WAIT_V(6); PG8_BAR; PG8_MMA(1, 1, At, B1); PG8_BAR;
            PG8_LDB(B0, 1, 0); PG8_SCHED; PG8_LDA(At, 1, 0); PG8_STAGE(PG8_SA(0, 1), a2 + hstep, voffA);
            PG8_WAIT_L(8); PG8_BAR; PG8_WAIT_L(0); PG8_MMA(0, 0, At, B0); PG8_BAR; PG8_SCHED;
            PG8_LDB(B1, 1, 1); PG8_STAGE(PG8_SB(1, 0), b3, voffB);
            PG8_BAR; PG8_WAIT_L(0); PG8_MMA(0, 1, At, B1); PG8_BAR;
            PG8_LDA(At, 1, 1); PG8_STAGE(PG8_SA(1, 0), a3, voffA);
            PG8_BAR; PG8_WAIT_L(0); PG8_MMA(1, 0, At, B0); PG8_BAR; PG8_SCHED;
            PG8_STAGE(PG8_SB(1, 1), b3 + hstep, voffB);
            PG8_WAIT_V(6); PG8_BAR; PG8_MMA(1, 1, At, B1); PG8_BAR;
            }
        }
        if constexpr (ALIGN_EPI) { if (wr == 0) PG8_BAR; }
        if constexpr (!Epi::AFTER_DRAIN) { E(acc, cur, wr, wc, fr, fq); S.done(cur); }
        if (!has_next) break;
#pragma unroll
        for (int a = 0; a < 2; ++a)
#pragma unroll
            for (int b = 0; b < 2; ++b)
#pragma unroll
                for (int m = 0; m < 4; ++m)
#pragma unroll
                    for (int n = 0; n < 2; ++n) acc[a][b][m][n] = (f32x4){0.f, 0.f, 0.f, 0.f};
        cur = nxt; cA = nA; cB = nB; ++ui;
        if constexpr (ALIGN_EPI) { if (wr == 1) PG8_BAR; }
    }
    PG8_WAIT_V(0);
    if constexpr (!ALIGN_EPI) { if (wr == 0) PG8_BAR; }
    PG8_BAR;
    if constexpr (Epi::AFTER_DRAIN) { E.fused(acc, cur, wr, wc, fr, fq, lds, wid, lane); S.done(cur); }
#undef PG8_SA
#undef PG8_SB
#undef PG8_STAGE
#undef PG8_LDA
#undef PG8_LDB
#undef PG8_MMA
#undef PG8_WAIT_V
#undef PG8_WAIT_L
#undef PG8_BAR
#undef PG8_SCHED
}
}

constexpr int NB = 16, SEQ = 2048, D = 1024, M = NB * SEQ, FF = 4096, PLE = 256, DIN = 3248, NZ = 3328;
constexpr float EPS = 1e-6f;
constexpr int ZQ = 0, ZK = 256, ZV = 512, ZG = 1024, ZRR = 1536, ZRK = 2048, ZRV = 2560, ZGK = 3072, ZLOW = 3088  ;
__host__ __device__ __forceinline__ int zmap(int n) { return n < 1536 ? n : (n < 1552 ? n + 1536 : (n < 3088 ? n - 16 : n)); }

constexpr size_t MiB = 1u << 20;
constexpr size_t WS_SS = 0;
constexpr size_t WS_WIN = 1 * MiB, WS_WOUT = 8 * MiB, WS_W1 = 10 * MiB, WS_W2 = 18 * MiB, WS_WG = 26 * MiB, WS_WP = 28 * MiB;
constexpr size_t WS_PB = 29 * MiB;
constexpr size_t WS_ABUF = 45 * MiB;
constexpr size_t WS_Z = 109 * MiB;
constexpr size_t WS_OCAT = 317 * MiB;
constexpr size_t WS_KF = 381 * MiB, WS_KK = 413 * MiB, WS_BB = 445 * MiB, WS_GG = 477 * MiB;
constexpr size_t WS_BON = 509 * MiB;
constexpr size_t WS_EL = 510 * MiB;
constexpr size_t WS_END = 512 * MiB;
constexpr size_t WS_VT = WS_ABUF, WS_HFF = WS_Z, WS_PP = WS_KF;
constexpr size_t DO_DEC = 0, DO_QT = 64 * MiB, DO_KT = 80 * MiB, DO_KDT = 96 * MiB;

constexpr int LDS_BYTES = 147456;

__device__ __forceinline__ float bf2f(bf16 b) { return __uint_as_float(((unsigned)b) << 16); }
__device__ __forceinline__ unsigned f2bf(float f) { unsigned u = __builtin_bit_cast(unsigned, f); return (u + 0x7fffu + ((u >> 16) & 1u)) >> 16; }
__device__ __forceinline__ unsigned pk2(float lo, float hi) { return f2bf(lo) | (f2bf(hi) << 16); }
#define LDS_WAIT() asm volatile("s_waitcnt lgkmcnt(0)" ::: "memory")
__device__ __forceinline__ float wave_sum(float v) {
#pragma unroll
    for (int o = 1; o < 64; o <<= 1) v += __shfl_xor(v, o);
    return v;
}
__device__ __forceinline__ float sigmoidf(float x) { return 1.0f / (1.0f + expf(-x)); }

struct Ptrs {
    const float* in[27]; float* out; unsigned char* ws;
};
enum { I_X = 0, I_P, I_LNMIX, I_WIN, I_CONVW, I_GKW, I_GKB, I_NORMG, I_MU, I_W0, I_W2, I_A0, I_A2, I_G2, I_KK, I_KA, I_RK, I_GNW, I_GNB, I_WOUT, I_LNMLP, I_WFF1, I_WFF2, I_LNPLE, I_WGATE, I_WPP, I_LNFIN };

template <bool ZMAP>
__device__ __forceinline__ void p0_transpose_item(const float* W, int K, int N, bf16* WT, LAS float* scr, int item, int lane) {
    const int nblk = (N + 31) / 32, kb = item / nblk, nb = item % nblk, k0 = 64 * kb, n0 = 32 * nb;
    { const int n = n0 + (lane & 31);
#pragma unroll 8
      for (int i = 0; i < 32; ++i) { const int kk = 2 * i + (lane >> 5); scr[kk * 33 + (lane & 31)] = (n < N) ? W[(size_t)(k0 + kk) * N + n] : 0.f; } }
    LDS_WAIT(); asm volatile("" ::: "memory");
    const int c = lane & 7;
#pragma unroll
    for (int j = 0; j < 4; ++j) { const int nl = (lane >> 3) + 8 * j, n = n0 + nl; const LAS float* s = scr + (8 * c) * 33 + nl;
        v4u o; o.x = pk2(s[0 * 33], s[1 * 33]); o.y = pk2(s[2 * 33], s[3 * 33]); o.z = pk2(s[4 * 33], s[5 * 33]); o.w = pk2(s[6 * 33], s[7 * 33]);
        if (n < N) { const int dst = ZMAP ? zmap(n) : n; *(v4u*)(WT + (size_t)dst * K + k0 + 8 * c) = o; } }
    LDS_WAIT(); asm volatile("" ::: "memory");
}
__device__ __forceinline__ void p0_prologue(const Ptrs& P, LAS unsigned char* lds, int tid, int lane, int wave) {
    unsigned char* ws = P.ws;
    LAS float* scr = (LAS float*)(lds + wave * 16384);
    const int gw = blockIdx.x * 8 + wave, NGW = gridDim.x * 8;
    const size_t gt = (size_t)blockIdx.x * 512 + tid, NGT = (size_t)gridDim.x * 512;
    constexpr int I_IN = 16 * 102, I_O = 16 * 32, I_1 = 16 * 128, I_2 = 64 * 32, I_G = 16 * 32, I_PP = 4 * 32;
    constexpr int NITEMS = I_IN + I_O + I_1 + I_2 + I_G + I_PP;
    for (int it = gw; it < NITEMS; it += NGW) {
        int r = it;
        if (r < I_IN) { p0_transpose_item<true>(P.in[I_WIN], D, DIN, (bf16*)(ws + WS_WIN), scr, r, lane); continue; } r -= I_IN;
        if (r < I_O) { p0_transpose_item<false>(P.in[I_WOUT], D, D, (bf16*)(ws + WS_WOUT), scr, r, lane); continue; } r -= I_O;
        if (r < I_1) { p0_transpose_item<false>(P.in[I_WFF1], D, FF, (bf16*)(ws + WS_W1), scr, r, lane); continue; } r -= I_1;
        if (r < I_2) { p0_transpose_item<false>(P.in[I_WFF2], FF, D, (bf16*)(ws + WS_W2), scr, r, lane); continue; } r -= I_2;
        if (r < I_G) { p0_transpose_item<false>(P.in[I_WGATE], D, D, (bf16*)(ws + WS_WG), scr, r, lane); continue; } r -= I_G;
        p0_transpose_item<false>(P.in[I_WPP], PLE, D, (bf16*)(ws + WS_WP), scr, r, lane);
    }
    { v4u* wp = (v4u*)((bf16*)(ws + WS_WIN) + (size_t)DIN * D); for (size_t i = gt; i < 10240; i += NGT) wp[i] = (v4u){0u, 0u, 0u, 0u};
      v4u* sp = (v4u*)(ws + WS_SS); for (size_t i = gt; i < 24576; i += NGT) sp[i] = (v4u){0u, 0u, 0u, 0u}; }
    { const float* g = P.in[I_LNMIX]; pg8::f32x4 gv[4];
#pragma unroll
      for (int j = 0; j < 4; ++j) gv[j] = *((const pg8::f32x4*)g + lane + 64 * j);
      bf16* XN = (bf16*)(ws + WS_ABUF);
      for (int m = gw; m < M; m += NGW) {
        const pg8::f32x4* xr = (const pg8::f32x4*)(P.in[I_X] + (size_t)m * D) + lane;
        pg8::f32x4 v[4]; float s = 0.f;
#pragma unroll
        for (int j = 0; j < 4; ++j) { v[j] = xr[64 * j]; s += (v[j][0] * v[j][0] + v[j][1] * v[j][1]) + (v[j][2] * v[j][2] + v[j][3] * v[j][3]); }
        const float rstd = 1.0f / sqrtf(wave_sum(s) * (1.0f / D) + EPS);
        v2u* o8 = (v2u*)(XN + (size_t)m * D) + lane;
#pragma unroll
        for (int j = 0; j < 4; ++j) { v2u w; w.x = pk2(v[j][0] * rstd * gv[j][0], v[j][1] * rstd * gv[j][1]); w.y = pk2(v[j][2] * rstd * gv[j][2], v[j][3] * rstd * gv[j][3]); o8[64 * j] = w; }
      } }
    { const pg8::f32x4* pp = (const pg8::f32x4*)P.in[I_P]; v2u* pb = (v2u*)(ws + WS_PB);
      for (size_t i = gt; i < (size_t)M * PLE / 4; i += NGT) { const pg8::f32x4 v = pp[i]; v2u w; w.x = pk2(v[0], v[1]); w.y = pk2(v[2], v[3]); pb[i] = w; } }
}

__device__ __forceinline__ void rwkv_pre(const Ptrs& P, LAS unsigned char* lds, int tid, int lane, int wave) {
    unsigned char* ws = P.ws;
    const bf16* Z = (const bf16*)(ws + WS_Z);
    float* DEC = (float*)((unsigned char*)P.out + DO_DEC);
    bf16 *KF = (bf16*)(ws + WS_KF), *KK = (bf16*)(ws + WS_KK), *BB = (bf16*)(ws + WS_BB), *GG = (bf16*)(ws + WS_GG);
    float* BON = (float*)(ws + WS_BON);
    const float* mu = P.in[I_MU];
    const int c = tid;
    float w2c[32], a2c[32], g2c[96];
#pragma unroll
    for (int i = 0; i < 32; ++i) { w2c[i] = P.in[I_W2][i * 512 + c]; a2c[i] = P.in[I_A2][i * 512 + c]; }
#pragma unroll
    for (int i = 0; i < 96; ++i) g2c[i] = P.in[I_G2][i * 512 + c];
    const float w0c = P.in[I_W0][c], a0c = P.in[I_A0][c], kkc = P.in[I_KK][c], kac = P.in[I_KA][c], rkc = P.in[I_RK][c];
    const float mur = mu[c], muk = mu[512 + c];
    LAS float* low = (LAS float*)lds;
    for (int item = blockIdx.x; item < M / 32; item += gridDim.x) {
        const int m0 = item * 32;
#pragma unroll 2
        for (int j = 0; j < 10; ++j) { const int idx = tid + 512 * j, tt = idx / 160, i = idx - tt * 160, m = m0 + tt;
            const float zc = bf2f(Z[(size_t)m * NZ + ZLOW + i]); const float zp = ((m & (SEQ - 1)) == 0) ? 0.f : bf2f(Z[(size_t)(m - 1) * NZ + ZLOW + i]);
            float x = zc + mu[1536 + i] * (zp - zc);
            if (i < 32) x = tanhf(x); else if (i >= 64) x = sigmoidf(x);
            low[idx] = x; }
        __syncthreads();
        float zrp, zkp;
        if ((m0 & (SEQ - 1)) == 0) { zrp = 0.f; zkp = 0.f; }
        else { zrp = bf2f(Z[(size_t)(m0 - 1) * NZ + ZRR + c]); zkp = bf2f(Z[(size_t)(m0 - 1) * NZ + ZRK + c]); }
#pragma unroll 1
        for (int tt = 0; tt < 32; ++tt) { const int m = m0 + tt;
            const float zr = bf2f(Z[(size_t)m * NZ + ZRR + c]), zk = bf2f(Z[(size_t)m * NZ + ZRK + c]);
            const float r = zr + mur * (zrp - zr), k = zk + muk * (zkp - zk); zrp = zr; zkp = zk;
            const LAS float* lw = low + tt * 160;
            float wa = w0c, aa = a0c, ga = 0.f;
#pragma unroll
            for (int i = 0; i < 32; ++i) { wa += lw[i] * w2c[i]; aa += lw[32 + i] * a2c[i]; }
#pragma unroll
            for (int i = 0; i < 96; ++i) ga += lw[64 + i] * g2c[i];
            const float nw = -wa;
            const float sp = fmaxf(nw, 0.f) + log1pf(expf(-fabsf(nw)));
            const float dec = expf(-expf(-sp - 0.5f));
            const float a = sigmoidf(aa);
            float kk = k * kkc; const float ssq = wave_sum(kk * kk); kk = kk / fmaxf(sqrtf(ssq), 1e-12f);
            const float kf = k * (1.0f + (a - 1.0f) * kac);
            const float bon = wave_sum(r * kf * rkc);
            const size_t o = (size_t)m * 512 + c;
            DEC[o] = dec; KF[o] = (bf16)f2bf(kf); KK[o] = (bf16)f2bf(kk); BB[o] = (bf16)f2bf(kk * a); GG[o] = (bf16)f2bf(ga);
            if (lane == 0) BON[(size_t)m * 8 + wave] = bon; }
        __syncthreads();
    }
}
__device__ __forceinline__ void gla_pre(const Ptrs& P, LAS unsigned char* lds, int tid, int lane, int wave) {
    unsigned char* ws = P.ws;
    const bf16* Z = (const bf16*)(ws + WS_Z);
    bf16 *QT = (bf16*)((unsigned char*)P.out + DO_QT), *KT = (bf16*)((unsigned char*)P.out + DO_KT), *KDT = (bf16*)((unsigned char*)P.out + DO_KDT), *VT = (bf16*)(ws + WS_VT);
    float* EL = (float*)(ws + WS_EL);
    LAS float* bbuf = (LAS float*)lds;
    const float* cwp = P.in[I_CONVW];
    for (int item = blockIdx.x; item < NB * 32; item += gridDim.x) {
        const int b = item >> 5, c = item & 31, mbase = b * SEQ + c * 64;
        if (tid < 256) { const int d = tid; float gkw[16];
#pragma unroll
            for (int i = 0; i < 16; ++i) gkw[i] = P.in[I_GKW][i * 256 + d];
            const float gkb = P.in[I_GKB][d]; float bc = 0.f;
#pragma unroll 1
            for (int t = 0; t < 64; ++t) { const bf16* zr = Z + (size_t)(mbase + t) * NZ + ZGK; float pre = gkb;
#pragma unroll
                for (int i = 0; i < 16; ++i) pre += bf2f(zr[i]) * gkw[i];
                const float ls = fminf(pre, 0.f) - log1pf(expf(-fabsf(pre)));
                bc += ls * (1.0f / 16.0f); bbuf[t * 256 + d] = bc; }
            EL[(size_t)(((b * 4 + (d >> 6)) * 32 + c) * 64) + (d & 63)] = expf(bc); }
        __syncthreads();
#pragma unroll 1
        for (int rep = 0; rep < 2; ++rep) { const int ch = tid + 512 * rep;
            const float cw0 = cwp[ch], cw1 = cwp[1024 + ch], cw2 = cwp[2048 + ch], cw3 = cwp[3072 + ch];
            float x3 = 0.f, x2 = 0.f, x1 = 0.f;
            if (c > 0) { x3 = bf2f(Z[(size_t)(mbase - 3) * NZ + ch]); x2 = bf2f(Z[(size_t)(mbase - 2) * NZ + ch]); x1 = bf2f(Z[(size_t)(mbase - 1) * NZ + ch]); }
            const int d = ch & 255, hq = d >> 6, dk = d & 63;
            const size_t tile = (size_t)((b * 4 + hq) * 32 + c) * 4096;
            const float blast = bbuf[63 * 256 + d];
            const int e = ch - 512, hv = e >> 7, dv = e & 127;
            const size_t vtile = (size_t)((b * 4 + hv) * 32 + c) * 8192;
#pragma unroll 1
            for (int t = 0; t < 64; ++t) { const float x = bf2f(Z[(size_t)(mbase + t) * NZ + ch]);
                const float y = cw0 * x3 + cw1 * x2 + cw2 * x1 + cw3 * x; x3 = x2; x2 = x1; x1 = x;
                const float s = y / (1.0f + expf(-y));
                if (ch < 256) { const float bt = bbuf[t * 256 + d]; QT[tile + t * 64 + dk] = (bf16)f2bf(s * 0.125f * expf(bt)); }
                else if (ch < 512) { const float bt = bbuf[t * 256 + d]; KT[tile + t * 64 + dk] = (bf16)f2bf(s * expf(-bt)); KDT[tile + dk * 64 + t] = (bf16)f2bf(s * expf(blast - bt)); }
                else { VT[vtile + dv * 64 + t] = (bf16)f2bf(s); } } }
        __syncthreads();
    }
}

__device__ __forceinline__ void rwkv_scan_naive(const Ptrs& P, LAS unsigned char* lds, int lane, int bh) {
    unsigned char* ws = P.ws;
    const bf16* Z = (const bf16*)(ws + WS_Z);
    const float* DEC = (const float*)((unsigned char*)P.out + DO_DEC);
    const bf16 *KF = (const bf16*)(ws + WS_KF), *KK = (const bf16*)(ws + WS_KK), *BB = (const bf16*)(ws + WS_BB), *GG = (const bf16*)(ws + WS_GG);
    const float* BON = (const float*)(ws + WS_BON);
    bf16* OCAT = (bf16*)(ws + WS_OCAT);
    const int b = bh >> 3, h = bh & 7, ch = h * 64 + lane;
    const float mur = P.in[I_MU][ch], muv = P.in[I_MU][1024 + ch], gnw = P.in[I_GNW][ch], gnb = P.in[I_GNB][ch];
    LAS float* vec = (LAS float*)lds;
    float s[64];
#pragma unroll
    for (int j = 0; j < 64; ++j) s[j] = 0.f;
    float zrp = 0.f, zvp = 0.f;
#pragma unroll 1
    for (int t0 = 0; t0 < SEQ; t0 += 16) {
#pragma unroll 4
        for (int tt = 0; tt < 16; ++tt) { const size_t m = (size_t)b * SEQ + t0 + tt;
            const float zr = bf2f(Z[m * NZ + ZRR + ch]), zv = bf2f(Z[m * NZ + ZRV + ch]);
            const float r = zr + mur * (zrp - zr), v = zv + muv * (zvp - zv); zrp = zr; zvp = zv;
            LAS float* vp = vec + tt * 384 + lane;
            vp[0] = DEC[m * 512 + ch]; vp[64] = -bf2f(KK[m * 512 + ch]); vp[128] = bf2f(BB[m * 512 + ch]); vp[192] = bf2f(KF[m * 512 + ch]); vp[256] = r; vp[320] = v; }
        LDS_WAIT(); asm volatile("" ::: "memory");
#pragma unroll 1
        for (int tt = 0; tt < 16; ++tt) { const size_t m = (size_t)b * SEQ + t0 + tt;
            const LAS float* vp = vec + tt * 384;
            const float v = vp[320 + lane];
            float sa = 0.f;
#pragma unroll
            for (int j = 0; j < 64; ++j) sa += s[j] * vp[64 + j];
            float y = 0.f;
#pragma unroll
            for (int j = 0; j < 64; ++j) { s[j] = s[j] * vp[j] + (sa * vp[128 + j] + v * vp[192 + j]); y += s[j] * vp[256 + j]; }
            const float mean = wave_sum(y) * (1.0f / 64.0f), dlt = y - mean;
            const float var = wave_sum(dlt * dlt) * (1.0f / 64.0f);
            float yn = dlt * (1.0f / sqrtf(var + 64e-5f)) * gnw + gnb;
            yn += BON[m * 8 + h] * v;
            OCAT[m * 1024 + 512 + ch] = (bf16)f2bf(yn * bf2f(GG[m * 512 + ch])); }
        LDS_WAIT(); asm volatile("" ::: "memory");
    }
}
__device__ __forceinline__ void gla_scan_naive(const Ptrs& P, int lane, int bh) {
    unsigned char* ws = P.ws;
    const bf16* Z = (const bf16*)(ws + WS_Z);
    const bf16 *QT = (const bf16*)((unsigned char*)P.out + DO_QT), *KT = (const bf16*)((unsigned char*)P.out + DO_KT), *VT = (const bf16*)(ws + WS_VT);
    const float* EL = (const float*)(ws + WS_EL);
    bf16* OCAT = (bf16*)(ws + WS_OCAT);
    const int b = bh >> 2, h = bh & 3;
    const float ng0 = P.in[I_NORMG][lane], ng1 = P.in[I_NORMG][64 + lane];
    float U0[64], U1[64];
#pragma unroll
    for (int d = 0; d < 64; ++d) { U0[d] = 0.f; U1[d] = 0.f; }
#pragma unroll 1
    for (int c = 0; c < 32; ++c) { const size_t tl = (size_t)(bh * 32 + c);
        const bf16 *qt = QT + tl * 4096, *kt = KT + tl * 4096, *vt = VT + tl * 8192;
#pragma unroll 1
        for (int t = 0; t < 64; ++t) { const size_t m = (size_t)b * SEQ + c * 64 + t;
            const float v0 = bf2f(vt[lane * 64 + t]), v1 = bf2f(vt[(64 + lane) * 64 + t]);
            float o0 = 0.f, o1 = 0.f;
#pragma unroll
            for (int d = 0; d < 64; ++d) { const float kd = bf2f(kt[t * 64 + d]), qd = bf2f(qt[t * 64 + d]);
                U0[d] += kd * v0; U1[d] += kd * v1; o0 += qd * U0[d]; o1 += qd * U1[d]; }
            const float rstd = 1.0f / sqrtf(wave_sum(o0 * o0 + o1 * o1) * (1.0f / 128.0f) + EPS);
            const float g0 = bf2f(Z[m * NZ + ZG + h * 128 + lane]), g1 = bf2f(Z[m * NZ + ZG + h * 128 + 64 + lane]);
            OCAT[m * 1024 + h * 128 + lane] = (bf16)f2bf(o0 * rstd * ng0 * (g0 / (1.0f + expf(-g0))));
            OCAT[m * 1024 + h * 128 + 64 + lane] = (bf16)f2bf(o1 * rstd * ng1 * (g1 / (1.0f + expf(-g1)))); }
        const float* el = EL + tl * 64;
#pragma unroll
        for (int d = 0; d < 64; ++d) { const float e = el[d]; U0[d] *= e; U1[d] *= e; } }
}

struct Args { const float* in[27]; float* out; unsigned char* ws; int ph_lo, ph_hi; };
constexpr int NPHASE = 9;
__global__ void __launch_bounds__(512, 2) mega(Args args) {
    extern __shared__ __attribute__((aligned(16))) unsigned char lds_raw[];
    LAS unsigned char* lds = (LAS unsigned char*)lds_raw;
    cg::grid_group grid = cg::this_grid();
    const int tid = threadIdx.x, lane = tid & 63, wave = __builtin_amdgcn_readfirstlane(tid >> 6);
    Ptrs P;
#pragma unroll
    for (int i = 0; i < 27; ++i) P.in[i] = args.in[i];
    P.out = args.out; P.ws = args.ws;
    unsigned char* ws = args.ws;
    const int lo = args.ph_lo, hi = args.ph_hi, G = gridDim.x, bx = blockIdx.x;
#define IN(k) (lo <= (k) && (k) < hi)
#define SEAM(k) do { if (IN(k) && IN((k) + 1)) grid.sync(); } while (0)
    float* SS2 = (float*)(ws + WS_SS); float* SS3 = SS2 + M; float* SS4 = SS3 + M;
    bf16* ABUF = (bf16*)(ws + WS_ABUF);

    if (IN(0)) { p0_prologue(P, lds, tid, lane, wave); } SEAM(0);
    if (IN(1)) {
        pg8::Gemm g{ABUF, (const bf16*)(ws + WS_WIN), M, NZ, D}; pg8::StaticOrder S; S.init(M, NZ, G, bx);
        pg8::EpiStoreBf16 E{(bf16*)(ws + WS_Z), NZ};
        pg8::gemm_phase<pg8::EpiStoreBf16, pg8::StaticOrder, true, true>(lds, g, S, E);
    } SEAM(1);
    if (IN(2)) { rwkv_pre(P, lds, tid, lane, wave); gla_pre(P, lds, tid, lane, wave); } SEAM(2);
    if (IN(3)) {
        if (wave == 0) { if (bx < 128) rwkv_scan_naive(P, lds, lane, bx); else if (bx < 192) gla_scan_naive(P, lane, bx - 128); }
    } SEAM(3);
    if (IN(4)) {
        { pg8::Gemm g{(const bf16*)(ws + WS_OCAT), (const bf16*)(ws + WS_WOUT), M, D, D}; pg8::StaticOrder S; S.init(M, D, G, bx);
          pg8::EpiRes E{P.in[I_X], P.out, ABUF, P.in[I_LNMLP], SS2};
          pg8::gemm_phase<pg8::EpiRes, pg8::StaticOrder, true, true>(lds, g, S, E); }
        { pg8::Gemm g{(const bf16*)(ws + WS_PB), (const bf16*)(ws + WS_WP), M, D, PLE}; pg8::StaticOrder S; S.init(M, D, G, bx);
          pg8::EpiStoreBf16 E{(bf16*)(ws + WS_PP), D};
          pg8::gemm_phase<pg8::EpiStoreBf16, pg8::StaticOrder, true, true>(lds, g, S, E); }
    } SEAM(4);
    if (IN(5)) {
        pg8::Gemm g{ABUF, (const bf16*)(ws + WS_W1), M, FF, D}; pg8::StaticOrder S; S.init(M, FF, G, bx);
        pg8::EpiFF1 E{(bf16*)(ws + WS_HFF), FF, SS2, EPS};
        pg8::gemm_phase<pg8::EpiFF1, pg8::StaticOrder, true, true>(lds, g, S, E);
    } SEAM(5);
    if (IN(6)) {
        pg8::Gemm g{(const bf16*)(ws + WS_HFF), (const bf16*)(ws + WS_W2), M, D, FF}; pg8::StaticOrder S; S.init(M, D, G, bx);
        pg8::EpiRes E{P.out, P.out, ABUF, P.in[I_LNPLE], SS3};
        pg8::gemm_phase<pg8::EpiRes, pg8::StaticOrder, true, true>(lds, g, S, E);
    } SEAM(6);
    if (IN(7)) {
        pg8::Gemm g{ABUF, (const bf16*)(ws + WS_WG), M, D, D}; pg8::StaticOrder S; S.init(M, D, G, bx);
        pg8::EpiGate E{P.out, (const bf16*)(ws + WS_PP), P.out, SS3, SS4, EPS};
        pg8::gemm_phase<pg8::EpiGate, pg8::StaticOrder, true, true>(lds, g, S, E);
    } SEAM(7);
    if (IN(8)) {
        const float* gf = P.in[I_LNFIN]; pg8::f32x4 gv[4];
#pragma unroll
        for (int j = 0; j < 4; ++j) gv[j] = *((const pg8::f32x4*)gf + lane + 64 * j);
        for (int m = bx * 8 + wave; m < M; m += G * 8) {
            const float rs = 1.0f / sqrtf(SS4[m] * (1.0f / D) + EPS);
            pg8::f32x4* orow = (pg8::f32x4*)(P.out + (size_t)m * D) + lane;
#pragma unroll
            for (int j = 0; j < 4; ++j) { pg8::f32x4 v = orow[64 * j]; v = v * rs * gv[j]; orow[64 * j] = v; }
        }
    }
#undef IN
#undef SEAM
}

#ifndef MK_ONE_LAUNCH
#define MK_ONE_LAUNCH 0
#endif
extern "C" void kernel_launch(void* const* d_in, const int* in_sizes, int n_in, void* d_out, int out_size, void* d_ws, size_t ws_size, hipStream_t stream) {
    static int grid = 0;
    if (grid == 0) {
        if (n_in != 27 || in_sizes[0] != M * D || out_size != M * D || ws_size < WS_END) { fprintf(stderr, "kernel_launch: unexpected shapes (n_in %d in0 %d out %d ws %zu)\n", n_in, n_in > 0 ? in_sizes[0] : -1, out_size, ws_size); grid = -1; return; }
        int dev = 0, cus = 0, per_cu = 0;
        (void)hipGetDevice(&dev); (void)hipDeviceGetAttribute(&cus, hipDeviceAttributeMultiprocessorCount, dev);
        if (hipFuncSetAttribute((const void*)mega, hipFuncAttributeMaxDynamicSharedMemorySize, LDS_BYTES) != hipSuccess) { fprintf(stderr, "kernel_launch: hipFuncSetAttribute failed\n"); grid = -1; return; }
        (void)hipOccupancyMaxActiveBlocksPerMultiprocessor(&per_cu, (const void*)mega, 512, LDS_BYTES);
        if (per_cu < 1) { fprintf(stderr, "kernel_launch: occupancy query says %d blocks per CU\n", per_cu); }
        (void)hipGetLastError();
        grid = cus;
    }
    if (grid < 0) return;
    Args a{};
    for (int i = 0; i < 27; ++i) a.in[i] = (const float*)d_in[i];
    a.out = (float*)d_out; a.ws = (unsigned char*)d_ws;
#if MK_ONE_LAUNCH
    a.ph_lo = 0; a.ph_hi = NPHASE;
    void* kargs[] = {&a};
    hipError_t e = hipLaunchCooperativeKernel((const void*)mega, dim3(grid), dim3(512), kargs, LDS_BYTES, stream);
    if (e != hipSuccess) fprintf(stderr, "kernel_launch: cooperative launch failed: %s (grid %d)\n", hipGetErrorString(e), grid);
#else
    for (int ph = 0; ph < NPHASE; ++ph) { a.ph_lo = ph; a.ph_hi = ph + 1; hipLaunchKernelGGL(mega, dim3(grid), dim3(512), LDS_BYTES, stream, a); }
#endif
}
```

```cpp
#include <hip/hip_runtime.h>
#include <hip/hip_cooperative_groups.h>
#include <cstdio>
#include <cstdint>
namespace cg = cooperative_groups;

#define GAS __attribute__((address_space(1)))
#define LAS __attribute__((address_space(3)))
typedef unsigned short bf16;
typedef unsigned v4u __attribute__((ext_vector_type(4)));
typedef unsigned v2u __attribute__((ext_vector_type(2)));

namespace pg8 {
#define PG8_LAS __attribute__((address_space(3)))
typedef unsigned short bf16_t;
typedef short bf16x8 __attribute__((ext_vector_type(8)));
typedef float f32x4 __attribute__((ext_vector_type(4)));
typedef unsigned u32x4 __attribute__((ext_vector_type(4)));
typedef unsigned u32x2 __attribute__((ext_vector_type(2)));
constexpr int BM = 256, BK = 64, HALF = 128, HTB = HALF * BK * 2  , STAGE_BYTES = 8 * HTB, NXCD = 8, WGM = 8;

__host__ __device__ __forceinline__ int lds_byte(int r, int c) { const int st = (r >> 4) * 2 + (c >> 5), rr = r & 15, cc = c & 31, ob = rr * 64 + cc * 2; return st * 1024 + (ob ^ (((ob >> 9) & 1) << 5)); }
__host__ __device__ __forceinline__ void stage_rc(int b, int& R, int& C) { const int st = b / 1024, sb = b % 1024, swz = sb ^ (((sb >> 9) & 1) << 5); R = (st >> 1) * 16 + swz / 64; C = (st & 1) * 32 + (swz % 64) / 2; }
__host__ __device__ __forceinline__ int perm32(int rho) { const int n = rho >> 4, i = rho & 15; return 8 * (i >> 2) + 4 * n + (i & 3); }

struct Unit { int pm, pn; };
struct Gemm { const bf16_t* A; const bf16_t* Bt; int M, N, K; };

struct StaticOrder {
    int nM, nN, nwg, G, c;
    __host__ __device__ void init(int M, int N, int G_, int c_) { nM = M / BM; nN = N / BM; nwg = nM * nN; G = G_; c = c_; }
    __host__ __device__ bool next(int i, Unit& u) const {
        const long L = (long)i * G + c; if (L >= nwg) return false;
        int wgid = (int)L; { const int q = nwg / NXCD, r = nwg % NXCD, xcd = wgid % NXCD, off = wgid / NXCD; wgid = (xcd < r ? xcd * (q + 1) : r * (q + 1) + (xcd - r) * q) + off; }
        const int nig = WGM * nN, gid = wgid / nig, fm = gid * WGM, gsz = (nM - fm) < WGM ? (nM - fm) : WGM;
        u.pm = fm + ((wgid % nig) % gsz); u.pn = (wgid % nig) / gsz; return true;
    }
    __device__ __forceinline__ void a_ready(const Unit&) const {}
    __device__ __forceinline__ void done(const Unit&) const {}
};

typedef float f32x2c __attribute__((ext_vector_type(2)));
typedef __bf16 bf16x2c __attribute__((ext_vector_type(2)));
__device__ __forceinline__ unsigned cvt_pk_bf16(float lo, float hi) { const f32x2c v = {lo, hi}; return __builtin_bit_cast(unsigned, __builtin_convertvector(v, bf16x2c)); }
__device__ __forceinline__ float bflo(unsigned w) { return __uint_as_float(w << 16); }
__device__ __forceinline__ float bfhi(unsigned w) { return __uint_as_float(w & 0xffff0000u); }
__device__ __forceinline__ void atomic_addf(float* p, float v) { __hip_atomic_fetch_add(p, v, __ATOMIC_RELAXED, __HIP_MEMORY_SCOPE_AGENT); }

struct EpiStoreBf16 {
    static constexpr bool PERM = true, AFTER_DRAIN = false;
    bf16_t* O; int ldc;
    __device__ __forceinline__ void operator()(const f32x4 (&acc)[2][2][4][2], const Unit& u, int wr, int wc, int fr, int fq) const {
        const int row0 = u.pm * BM + wr * 64 + fr, col0 = u.pn * BM + wc * 32 + 8 * fq;
#pragma unroll
        for (int ai = 0; ai < 2; ++ai)
#pragma unroll
            for (int m = 0; m < 4; ++m) { bf16_t* rowp = O + (size_t)(row0 + ai * HALF + m * 16) * ldc + col0;
#pragma unroll
                for (int bj = 0; bj < 2; ++bj) { const f32x4 v0 = acc[ai][bj][m][0], v1 = acc[ai][bj][m][1];
                    u32x4 w; w.x = cvt_pk_bf16(v0[0], v0[1]); w.y = cvt_pk_bf16(v0[2], v0[3]); w.z = cvt_pk_bf16(v1[0], v1[1]); w.w = cvt_pk_bf16(v1[2], v1[3]);
                    *(u32x4*)(rowp + bj * HALF) = w; } }
    }
};
struct EpiFF1 {
    static constexpr bool PERM = true, AFTER_DRAIN = false;
    bf16_t* O; int ldc; const float* ss; float eps;
    __device__ __forceinline__ void operator()(const f32x4 (&acc)[2][2][4][2], const Unit& u, int wr, int wc, int fr, int fq) const {
        const int row0 = u.pm * BM + wr * 64 + fr, col0 = u.pn * BM + wc * 32 + 8 * fq;
#pragma unroll
        for (int ai = 0; ai < 2; ++ai)
#pragma unroll
            for (int m = 0; m < 4; ++m) { const int row = row0 + ai * HALF + m * 16; bf16_t* rowp = O + (size_t)row * ldc + col0;
                const float rs = 1.0f / sqrtf(ss[row] * (1.0f / 1024.0f) + eps);
#pragma unroll
                for (int bj = 0; bj < 2; ++bj) { f32x4 v0 = acc[ai][bj][m][0] * rs, v1 = acc[ai][bj][m][1] * rs;
#pragma unroll
                    for (int j = 0; j < 4; ++j) { const float a = fmaxf(v0[j], 0.f), b = fmaxf(v1[j], 0.f); v0[j] = a * a; v1[j] = b * b; }
                    u32x4 w; w.x = cvt_pk_bf16(v0[0], v0[1]); w.y = cvt_pk_bf16(v0[2], v0[3]); w.z = cvt_pk_bf16(v1[0], v1[1]); w.w = cvt_pk_bf16(v1[2], v1[3]);
                    *(u32x4*)(rowp + bj * HALF) = w; } }
    }
};
template <bool BASE_BF16> struct EpiRes {
    static constexpr bool PERM = false, AFTER_DRAIN = false;
    const float* basef; const bf16_t* baseb; const float* gprev; bf16_t* A; const float* gain; float* ss;
    __device__ __forceinline__ void operator()(const f32x4 (&acc)[2][2][4][2], const Unit& u, int wr, int wc, int fr, int fq) const {
        const int row0 = u.pm * BM + wr * 64 + fr, col0 = u.pn * BM + wc * 32 + 4 * fq;
        f32x4 gv[2][2], gi[2][2];
#pragma unroll
        for (int bj = 0; bj < 2; ++bj)
#pragma unroll
            for (int n = 0; n < 2; ++n) { gv[bj][n] = *(const f32x4*)(gain + col0 + bj * HALF + n * 16);
                if (BASE_BF16) { const f32x4 gp = *(const f32x4*)(gprev + col0 + bj * HALF + n * 16); gi[bj][n] = (f32x4){1.0f / gp[0], 1.0f / gp[1], 1.0f / gp[2], 1.0f / gp[3]}; } }
#pragma unroll
        for (int ai = 0; ai < 2; ++ai)
#pragma unroll
            for (int m = 0; m < 4; ++m) { const int row = row0 + ai * HALF + m * 16; const size_t off = (size_t)row * 1024 + col0; float q = 0.f;
#pragma unroll
                for (int bj = 0; bj < 2; ++bj)
#pragma unroll
                    for (int n = 0; n < 2; ++n) { const size_t o = off + bj * HALF + n * 16; f32x4 bs;
                        if (BASE_BF16) { const u32x2 bw = *(const u32x2*)(baseb + o); bs = (f32x4){bflo(bw.x), bfhi(bw.x), bflo(bw.y), bfhi(bw.y)} * gi[bj][n]; }
                        else bs = *(const f32x4*)(basef + o);
                        const f32x4 h = bs + acc[ai][bj][m][n];
                        q += (h[0] * h[0] + h[1] * h[1]) + (h[2] * h[2] + h[3] * h[3]);
                        const f32x4 a = h * gv[bj][n]; u32x2 w; w.x = cvt_pk_bf16(a[0], a[1]); w.y = cvt_pk_bf16(a[2], a[3]); *(u32x2*)(A + o) = w; }
                q += __shfl_xor(q, 16); q += __shfl_xor(q, 32);
                if (fq == 0) atomic_addf(ss + row, q);
                asm volatile("" ::: "memory"); }
    }
};
struct EpiGate {
    static constexpr bool PERM = false, AFTER_DRAIN = false;
    const bf16_t* hb; const float* gprev; const bf16_t* pp; float* out; const float* ss_in; float* ss_out; float eps;
    __device__ __forceinline__ void operator()(const f32x4 (&acc)[2][2][4][2], const Unit& u, int wr, int wc, int fr, int fq) const {
        const int row0 = u.pm * BM + wr * 64 + fr, col0 = u.pn * BM + wc * 32 + 4 * fq;
        f32x4 gi[2][2];
#pragma unroll
        for (int bj = 0; bj < 2; ++bj)
#pragma unroll
            for (int n = 0; n < 2; ++n) { const f32x4 gp = *(const f32x4*)(gprev + col0 + bj * HALF + n * 16); gi[bj][n] = (f32x4){1.0f / gp[0], 1.0f / gp[1], 1.0f / gp[2], 1.0f / gp[3]}; }
#pragma unroll
        for (int ai = 0; ai < 2; ++ai)
#pragma unroll
            for (int m = 0; m < 4; ++m) { const int row = row0 + ai * HALF + m * 16; const size_t off = (size_t)row * 1024 + col0; float q = 0.f;
                const float rs = 1.0f / sqrtf(ss_in[row] * (1.0f / 1024.0f) + eps);
#pragma unroll
                for (int bj = 0; bj < 2; ++bj)
#pragma unroll
                    for (int n = 0; n < 2; ++n) { const size_t o = off + bj * HALF + n * 16; const u32x2 hw = *(const u32x2*)(hb + o); const f32x4 hv = (f32x4){bflo(hw.x), bfhi(hw.x), bflo(hw.y), bfhi(hw.y)} * gi[bj][n]; const u32x2 pw = *(const u32x2*)(pp + o);
                        const f32x4 g = acc[ai][bj][m][n] * rs; f32x4 r;
                        r[0] = hv[0] + bflo(pw.x) / (1.0f + __expf(-g[0])); r[1] = hv[1] + bfhi(pw.x) / (1.0f + __expf(-g[1]));
                        r[2] = hv[2] + bflo(pw.y) / (1.0f + __expf(-g[2])); r[3] = hv[3] + bfhi(pw.y) / (1.0f + __expf(-g[3]));
                        *(f32x4*)(out + o) = r; q += (r[0] * r[0] + r[1] * r[1]) + (r[2] * r[2] + r[3] * r[3]); }
                q += __shfl_xor(q, 16); q += __shfl_xor(q, 32);
                if (fq == 0) atomic_addf(ss_out + row, q);
                asm volatile("" ::: "memory"); }
    }
};

template <class Epi, class Sched, bool ALIGN_EPI = false, bool SP2 = false>
__device__ __forceinline__ void gemm_phase(PG8_LAS unsigned char* lds, const Gemm g, const Sched& S, const Epi& E) {
    const int tid = threadIdx.x, wid = __builtin_amdgcn_readfirstlane(tid >> 6), lane = tid & 63, wr = wid >> 2, wc = wid & 3, fr = lane & 15, fq = lane >> 4;
    const int K = g.K, nt = K / BK;
    unsigned voffA[2], voffB[2];
#pragma unroll
    for (int i = 0; i < 2; ++i) { int R, C; stage_rc(tid * 16 + i * 8192, R, C); const int Rb = Epi::PERM ? ((R & ~31) + perm32(R & 31)) : R;
        voffA[i] = (unsigned)(R * K + C) * 2u; voffB[i] = (unsigned)(Rb * K + C) * 2u; }
    const size_t kstep = (size_t)(BK * 2);
    const size_t hstep = (size_t)HALF * K * 2;
    const size_t tstep = 2 * hstep;
    const unsigned ldsw = (unsigned)wid * 1024u;
    const int aoff = lds_byte(wr * 64 + fr, fq * 8), boff = lds_byte(wc * 32 + fr, fq * 8);
#define PG8_SA(b, h) (((b) * 2 + (h)) * HTB)
#define PG8_SB(b, h) ((4 + (b) * 2 + (h)) * HTB)
#define PG8_STAGE(bufoff, gbase, voff) do { _Pragma("unroll") for (int _i = 0; _i < 2; ++_i) \
        __builtin_amdgcn_global_load_lds((const unsigned*)((const char*)(gbase) + (voff)[_i]), (PG8_LAS unsigned*)(lds + (bufoff) + ldsw + _i * 8192), 16, 0, 0); } while (0)
#define PG8_LDA(dst, b, h) do { _Pragma("unroll") for (int m = 0; m < 4; ++m) _Pragma("unroll") for (int k = 0; k < 2; ++k) dst[m][k] = *(const PG8_LAS bf16x8*)(lds + PG8_SA(b, h) + aoff + m * 2048 + k * 1024); } while (0)
#define PG8_LDB(dst, b, h) do { _Pragma("unroll") for (int n = 0; n < 2; ++n) _Pragma("unroll") for (int k = 0; k < 2; ++k) dst[n][k] = *(const PG8_LAS bf16x8*)(lds + PG8_SB(b, h) + boff + n * 2048 + k * 1024); } while (0)
#define PG8_MMA(ai, bj, At, Bt) do { __builtin_amdgcn_s_setprio(1); _Pragma("unroll") for (int m = 0; m < 4; ++m) _Pragma("unroll") for (int n = 0; n < 2; ++n) _Pragma("unroll") for (int k = 0; k < 2; ++k) \
        acc[ai][bj][m][n] = __builtin_amdgcn_mfma_f32_16x16x32_bf16(Bt[n][k], At[m][k], acc[ai][bj][m][n], 0, 0, 0); __builtin_amdgcn_s_setprio(0); } while (0)
#define PG8_WAIT_V(n) asm volatile("s_waitcnt vmcnt(" #n ")" ::: "memory")
#define PG8_WAIT_L(n) asm volatile("s_waitcnt lgkmcnt(" #n ")" ::: "memory")
#define PG8_BAR __builtin_amdgcn_s_barrier()
#define PG8_SCHED __builtin_amdgcn_sched_barrier(0)
    Unit cur, nxt; int ui = 0;
    if (!S.next(0, cur)) return;
    f32x4 acc[2][2][4][2];
#pragma unroll
    for (int a = 0; a < 2; ++a)
#pragma unroll
        for (int b = 0; b < 2; ++b)
#pragma unroll
            for (int m = 0; m < 4; ++m)
#pragma unroll
                for (int n = 0; n < 2; ++n) acc[a][b][m][n] = (f32x4){0.f, 0.f, 0.f, 0.f};
    bf16x8 At[4][2], B0[2][2], B1[2][2];
    const char* cA = (const char*)g.A + (size_t)cur.pm * tstep; const char* cB = (const char*)g.Bt + (size_t)cur.pn * tstep;
    S.a_ready(cur);
    if constexpr (SP2) {
        PG8_STAGE(PG8_SB(0, 0), cB, voffB); PG8_STAGE(PG8_SB(0, 1), cB + hstep, voffB); PG8_STAGE(PG8_SA(0, 0), cA, voffA); PG8_STAGE(PG8_SA(0, 1), cA + hstep, voffA);
        if (wr == 1) PG8_BAR;
        PG8_WAIT_V(2); PG8_BAR;
        PG8_STAGE(PG8_SB(1, 0), cB + kstep, voffB); PG8_STAGE(PG8_SA(1, 0), cA + kstep, voffA); PG8_STAGE(PG8_SB(1, 1), cB + hstep + kstep, voffB);
        PG8_WAIT_V(6); PG8_BAR;
    } else {
        PG8_STAGE(PG8_SB(0, 0), cB, voffB); PG8_STAGE(PG8_SA(0, 0), cA, voffA); PG8_STAGE(PG8_SB(0, 1), cB + hstep, voffB); PG8_STAGE(PG8_SA(0, 1), cA + hstep, voffA);
        if (wr == 1) PG8_BAR;
        PG8_WAIT_V(4); PG8_BAR;
        PG8_STAGE(PG8_SB(1, 0), cB + kstep, voffB); PG8_STAGE(PG8_SA(1, 0), cA + kstep, voffA); PG8_STAGE(PG8_SB(1, 1), cB + hstep + kstep, voffB);
        PG8_WAIT_V(6); PG8_BAR;
    }
    for (;;) {
        const bool has_next = S.next(ui + 1, nxt);
        const char* nA = has_next ? (const char*)g.A + (size_t)nxt.pm * tstep : cA; const char* nB = has_next ? (const char*)g.Bt + (size_t)nxt.pn * tstep : cB;
        for (int t = 0; t < nt; t += 2) {
            const bool last = (t == nt - 2);
            const char* a1 = cA + (size_t)(t + 1) * kstep;
            const char* a2 = last ? nA : cA + (size_t)(t + 2) * kstep; const char* b2 = last ? nB : cB + (size_t)(t + 2) * kstep;
            const char* a3 = a2 + kstep; const char* b3 = b2 + kstep;
            if (last && has_next) S.a_ready(nxt);
            if constexpr (SP2) {
            PG8_LDB(B0, 0, 0); PG8_LDB(B1, 0, 1); PG8_SCHED; PG8_LDA(At, 0, 0); PG8_STAGE(PG8_SA(1, 1), a1 + hstep, voffA);
            PG8_WAIT_V(8); PG8_WAIT_L(0); PG8_BAR; PG8_MMA(0, 0, At, B0); PG8_MMA(0, 1, At, B1); PG8_BAR; PG8_SCHED;
            PG8_LDA(At, 0, 1); PG8_STAGE(PG8_SB(0, 0), b2, voffB); PG8_STAGE(PG8_SB(0, 1), b2 + hstep, voffB); PG8_STAGE(PG8_SA(0, 0), a2, voffA);
            PG8_WAIT_V(8); PG8_WAIT_L(0); PG8_BAR; PG8_MMA(1, 0, At, B0); PG8_MMA(1, 1, At, B1); PG8_BAR; PG8_SCHED;
            PG8_LDB(B0, 1, 0); PG8_LDB(B1, 1, 1); PG8_SCHED; PG8_LDA(At, 1, 0); PG8_STAGE(PG8_SA(0, 1), a2 + hstep, voffA);
            PG8_WAIT_V(8); PG8_WAIT_L(0); PG8_BAR; PG8_MMA(0, 0, At, B0); PG8_MMA(0, 1, At, B1); PG8_BAR; PG8_SCHED;
            PG8_LDA(At, 1, 1); PG8_STAGE(PG8_SB(1, 0), b3, voffB); PG8_STAGE(PG8_SB(1, 1), b3 + hstep, voffB); PG8_STAGE(PG8_SA(1, 0), a3, voffA);
            PG8_WAIT_V(8); PG8_WAIT_L(0); PG8_BAR; PG8_MMA(1, 0, At, B0); PG8_MMA(1, 1, At, B1); PG8_BAR; PG8_SCHED;
            } else {
            PG8_LDB(B0, 0, 0); PG8_SCHED; PG8_LDA(At, 0, 0); PG8_STAGE(PG8_SA(1, 1), a1 + hstep, voffA);
            PG8_WAIT_L(8); PG8_BAR; PG8_WAIT_L(0); PG8_MMA(0, 0, At, B0); PG8_BAR; PG8_SCHED;
            PG8_LDB(B1, 0, 1); PG8_STAGE(PG8_SB(0, 0), b2, voffB);
            PG8_BAR; PG8_WAIT_L(0); PG8_MMA(0, 1, At, B1); PG8_BAR;
            PG8_LDA(At, 0, 1); PG8_STAGE(PG8_SA(0, 0), a2, voffA);
            PG8_BAR; PG8_WAIT_L(0); PG8_MMA(1, 0, At, B0); PG8_BAR; PG8_SCHED;
            PG8_STAGE(PG8_SB(0, 1), b2 + hstep, voffB);
            PG8_WAIT_V(6); PG8_BAR; PG8_MMA(1, 1, At, B1); PG8_BAR;
            PG8_LDB(B0, 1, 0); PG8_SCHED; PG8_LDA(At, 1, 0); PG8_STAGE(PG8_SA(0, 1), a2 + hstep, voffA);
            PG8_WAIT_L(8); PG8_BAR; PG8_WAIT_L(0); PG8_MMA(0, 0, At, B0); PG8_BAR; PG8_SCHED;
            PG8_LDB(B1, 1, 1); PG8_STAGE(PG8_SB(1, 0), b3, voffB);
            PG8_BAR; PG8_WAIT_L(0); PG8_MMA(0, 1, At, B1); PG8_BAR;
            PG8_LDA(At, 1, 1); PG8_STAGE(PG8_SA(1, 0), a3, voffA);
            PG8_BAR; PG8_WAIT_L(0); PG8_MMA(1, 0, At, B0); PG8_BAR; PG8_SCHED;
            PG8_STAGE(PG8_SB(1, 1), b3 + hstep, voffB);
            PG8_WAIT_V(6); PG8_BAR; PG8_MMA(1, 1, At, B1); PG8_BAR;
            }
        }
        if constexpr (ALIGN_EPI) { if (wr == 0) PG8_BAR; }
        if constexpr (!Epi::AFTER_DRAIN) { E(acc, cur, wr, wc, fr, fq); S.done(cur); }
        if (!has_next) break;
#pragma unroll
        for (int a = 0; a < 2; ++a)
#pragma unroll
            for (int b = 0; b < 2; ++b)
#pragma unroll
                for (int m = 0; m < 4; ++m)
#pragma unroll
                    for (int n = 0; n < 2; ++n) acc[a][b][m][n] = (f32x4){0.f, 0.f, 0.f, 0.f};
        cur = nxt; cA = nA; cB = nB; ++ui;
        if constexpr (ALIGN_EPI) { if (wr == 1) PG8_BAR; }
    }
    PG8_WAIT_V(0);
    if constexpr (!ALIGN_EPI) { if (wr == 0) PG8_BAR; }
    PG8_BAR;
    if constexpr (Epi::AFTER_DRAIN) { E.fused(acc, cur, wr, wc, fr, fq, lds, wid, lane); S.done(cur); }
#undef PG8_SA
#undef PG8_SB
#undef PG8_STAGE
#undef PG8_LDA
#undef PG8_LDB
#undef PG8_MMA
#undef PG8_WAIT_V
#undef PG8_WAIT_L
#undef PG8_BAR
#undef PG8_SCHED
}
}
#ifndef PROBE_DUP
#define PROBE_DUP 0
#endif
#ifndef PROBE_RWB
#define PROBE_RWB 0
#endif
#ifndef PROBE_RWA
#define PROBE_RWA 0
#endif

constexpr int NB = 16, SEQ = 2048, D = 1024, M = NB * SEQ, FF = 4096, PLE = 256, DIN = 3248, NZ = 3328;
constexpr float EPS = 1e-6f;
constexpr int ZQ = 0, ZK = 256, ZV = 512, ZG = 1024, ZRR = 1536, ZRK = 2048, ZRV = 2560, ZGK = 3072, ZLOW = 3088  ;
__host__ __device__ __forceinline__ int zmap(int n) { return n < 1536 ? n : (n < 1552 ? n + 1536 : (n < 3088 ? n - 16 : n)); }

constexpr size_t MiB = 1u << 20;
constexpr size_t WS_LWT = 512 * 1024;
constexpr size_t WS_BAR = 768 * 1024;
constexpr size_t WS_SS = 0;
constexpr size_t WS_WIN = 1 * MiB, WS_WOUT = 8 * MiB, WS_W1 = 10 * MiB, WS_W2 = 18 * MiB, WS_WG = 26 * MiB, WS_WP = 28 * MiB;
constexpr size_t WS_PB = 29 * MiB;
constexpr size_t WS_ABUF = 45 * MiB;
constexpr size_t WS_Z = 109 * MiB;
constexpr size_t WS_OCAT = 317 * MiB;
constexpr size_t WS_KF = 381 * MiB, WS_KK = 413 * MiB, WS_BB = 445 * MiB, WS_GG = 477 * MiB;
constexpr size_t WS_BON = 509 * MiB;
constexpr size_t WS_EL = 510 * MiB;
constexpr size_t WS_END = 512 * MiB;
constexpr size_t WS_VT = WS_ABUF, WS_HFF = WS_Z, WS_PP = WS_KF, WS_H3 = WS_Z;
constexpr size_t DO_DEC = 0, DO_QT = 64 * MiB, DO_KT = 80 * MiB, DO_KDT = 96 * MiB;

constexpr int LDS_BYTES = 147456, LDS_MISC = 147000;

__device__ __forceinline__ float bf2f(bf16 b) { return __uint_as_float(((unsigned)b) << 16); }
typedef float f32x2_t __attribute__((ext_vector_type(2)));
typedef __bf16 bf16x2_t __attribute__((ext_vector_type(2)));
__device__ __forceinline__ unsigned pk2(float lo, float hi) { const f32x2_t v = {lo, hi}; return __builtin_bit_cast(unsigned, __builtin_convertvector(v, bf16x2_t)); }
__device__ __forceinline__ unsigned f2bf(float f) { return pk2(f, f) & 0xffffu; }
#define LDS_WAIT() asm volatile("s_waitcnt lgkmcnt(0)" ::: "memory")
__device__ __forceinline__ float wave_sum(float v) {
#pragma unroll
    for (int o = 1; o < 64; o <<= 1) v += __shfl_xor(v, o);
    return v;
}
__device__ __forceinline__ float sigmoidf(float x) { return 1.0f / (1.0f + expf(-x)); }

struct Ptrs {
    const float* in[27]; float* out; unsigned char* ws;
};
enum { I_X = 0, I_P, I_LNMIX, I_WIN, I_CONVW, I_GKW, I_GKB, I_NORMG, I_MU, I_W0, I_W2, I_A0, I_A2, I_G2, I_KK, I_KA, I_RK, I_GNW, I_GNB, I_WOUT, I_LNMLP, I_WFF1, I_WFF2, I_LNPLE, I_WGATE, I_WPP, I_LNFIN };

template <bool ZMAP>
__device__ __forceinline__ void p0_transpose_item(const float* W, int K, int N, bf16* WT, LAS float* scr, int item, int lane) {
    const int nblk = (N + 31) / 32, kb = item / nblk, nb = item % nblk, k0 = 64 * kb, n0 = 32 * nb;
    { const int n = n0 + (lane & 31);
#pragma unroll 8
      for (int i = 0; i < 32; ++i) { const int kk = 2 * i + (lane >> 5); scr[kk * 33 + (lane & 31)] = (n < N) ? W[(size_t)(k0 + kk) * N + n] : 0.f; } }
    LDS_WAIT(); asm volatile("" ::: "memory");
    const int c = lane & 7;
#pragma unroll
    for (int j = 0; j < 4; ++j) { const int nl = (lane >> 3) + 8 * j, n = n0 + nl; const LAS float* s = scr + (8 * c) * 33 + nl;
        v4u o; o.x = pk2(s[0 * 33], s[1 * 33]); o.y = pk2(s[2 * 33], s[3 * 33]); o.z = pk2(s[4 * 33], s[5 * 33]); o.w = pk2(s[6 * 33], s[7 * 33]);
        if (n < N) { const int dst = ZMAP ? zmap(n) : n; *(v4u*)(WT + (size_t)dst * K + k0 + 8 * c) = o; } }
    LDS_WAIT(); asm volatile("" ::: "memory");
}
__device__ __forceinline__ void p0_late_weights(const Ptrs& P, LAS unsigned char* lds, int tid, int lane, int wave, int wk, int nwk) {
    unsigned char* ws = P.ws;
    LAS float* scr = (LAS float*)(lds + wave * 16384);
    const int gw = wk * 8 + wave, NGW = nwk * 8;
    const size_t gt = (size_t)wk * 512 + tid, NGT = (size_t)nwk * 512;
    constexpr int I_O = 16 * 32, I_1 = 16 * 128, I_2 = 64 * 32, I_G = 16 * 32, I_PP = 4 * 32;
    constexpr int NITEMS = I_O + I_1 + I_2 + I_G + I_PP;
    for (int it = gw; it < NITEMS; it += NGW) {
        int r = it;
        if (r < I_PP) { p0_transpose_item<false>(P.in[I_WPP], PLE, D, (bf16*)(ws + WS_WP), scr, r, lane); continue; } r -= I_PP;
        if (r < I_O) { p0_transpose_item<false>(P.in[I_WOUT], D, D, (bf16*)(ws + WS_WOUT), scr, r, lane); continue; } r -= I_O;
        if (r < I_1) { p0_transpose_item<false>(P.in[I_WFF1], D, FF, (bf16*)(ws + WS_W1), scr, r, lane); continue; } r -= I_1;
        if (r < I_2) { p0_transpose_item<false>(P.in[I_WFF2], FF, D, (bf16*)(ws + WS_W2), scr, r, lane); continue; } r -= I_2;
        p0_transpose_item<false>(P.in[I_WGATE], D, D, (bf16*)(ws + WS_WG), scr, r, lane);
    }
    { const pg8::f32x4* pp = (const pg8::f32x4*)P.in[I_P]; v2u* pb = (v2u*)(ws + WS_PB);
      for (size_t i = gt; i < (size_t)M * PLE / 4; i += NGT) { const pg8::f32x4 v = pp[i]; v2u w; w.x = pk2(v[0], v[1]); w.y = pk2(v[2], v[3]); pb[i] = w; } }
}
__device__ __forceinline__ void p0_prologue(const Ptrs& P, LAS unsigned char* lds, int tid, int lane, int wave) {
    unsigned char* ws = P.ws;
    LAS float* scr = (LAS float*)(lds + wave * 16384);
    const int gw = blockIdx.x * 8 + wave, NGW = gridDim.x * 8;
    const size_t gt = (size_t)blockIdx.x * 512 + tid, NGT = (size_t)gridDim.x * 512;
    constexpr int I_IN = 16 * 102;
    for (int it = gw; it < I_IN; it += NGW) p0_transpose_item<true>(P.in[I_WIN], D, DIN, (bf16*)(ws + WS_WIN), scr, it, lane);
    { v4u* wp = (v4u*)((bf16*)(ws + WS_WIN) + (size_t)DIN * D); for (size_t i = gt; i < 10240; i += NGT) wp[i] = (v4u){0u, 0u, 0u, 0u};
      v4u* sp = (v4u*)(ws + WS_SS); for (size_t i = gt; i < 24576; i += NGT) sp[i] = (v4u){0u, 0u, 0u, 0u}; }
    { bf16* LWT = (bf16*)(ws + WS_LWT);
      for (size_t i = gt; i < 512 * 160; i += NGT) { const int c = (int)(i / 160), k = (int)(i % 160);
          const float v = k < 32 ? P.in[I_W2][k * 512 + c] : (k < 64 ? P.in[I_A2][(k - 32) * 512 + c] : P.in[I_G2][(k - 64) * 512 + c]);
          LWT[i] = (bf16)f2bf(v); } }
    { const float* g = P.in[I_LNMIX]; pg8::f32x4 gv[4];
#pragma unroll
      for (int j = 0; j < 4; ++j) gv[j] = *((const pg8::f32x4*)g + lane + 64 * j);
      bf16* XN = (bf16*)(ws + WS_ABUF);
      pg8::f32x4 v[4], vn[4];
      if (gw < M) { const pg8::f32x4* xr = (const pg8::f32x4*)(P.in[I_X] + (size_t)gw * D) + lane;
#pragma unroll
          for (int j = 0; j < 4; ++j) v[j] = xr[64 * j]; }
      for (int m = gw; m < M; m += NGW) {
        if (m + NGW < M) { const pg8::f32x4* xr = (const pg8::f32x4*)(P.in[I_X] + (size_t)(m + NGW) * D) + lane;
#pragma unroll
            for (int j = 0; j < 4; ++j) vn[j] = xr[64 * j]; }
        float s = 0.f;
#pragma unroll
        for (int j = 0; j < 4; ++j) s += (v[j][0] * v[j][0] + v[j][1] * v[j][1]) + (v[j][2] * v[j][2] + v[j][3] * v[j][3]);
        const float rstd = 1.0f / sqrtf(wave_sum(s) * (1.0f / D) + EPS);
        v2u* o8 = (v2u*)(XN + (size_t)m * D) + lane;
#pragma unroll
        for (int j = 0; j < 4; ++j) { v2u w; w.x = pk2(v[j][0] * rstd * gv[j][0], v[j][1] * rstd * gv[j][1]); w.y = pk2(v[j][2] * rstd * gv[j][2], v[j][3] * rstd * gv[j][3]); o8[64 * j] = w; }
#pragma unroll
        for (int j = 0; j < 4; ++j) v[j] = vn[j];
      } }
}

__device__ __forceinline__ void rwkv_pre(const Ptrs& P, LAS unsigned char* lds, int tid, int lane, int wave) {
    unsigned char* ws = P.ws;
    const bf16* Z = (const bf16*)(ws + WS_Z);
    float* DEC = (float*)((unsigned char*)P.out + DO_DEC);
    bf16 *KF = (bf16*)(ws + WS_KF), *KK = (bf16*)(ws + WS_KK), *BB = (bf16*)(ws + WS_BB), *GG = (bf16*)(ws + WS_GG);
    float* BON = (float*)(ws + WS_BON);
    const float* mu = P.in[I_MU];
    const int c = tid;
    float w2c[32], a2c[32], g2c[96];
#pragma unroll
    for (int i = 0; i < 32; ++i) { w2c[i] = P.in[I_W2][i * 512 + c]; a2c[i] = P.in[I_A2][i * 512 + c]; }
#pragma unroll
    for (int i = 0; i < 96; ++i) g2c[i] = P.in[I_G2][i * 512 + c];
    const float w0c = P.in[I_W0][c], a0c = P.in[I_A0][c], kkc = P.in[I_KK][c], kac = P.in[I_KA][c], rkc = P.in[I_RK][c];
    const float mur = mu[c], muk = mu[512 + c];
    LAS float* low = (LAS float*)lds;
    for (int item = blockIdx.x; item < M / 32; item += gridDim.x) {
        const int m0 = item * 32;
#pragma unroll 2
        for (int j = 0; j < 10; ++j) { const int idx = tid + 512 * j, tt = idx / 160, i = idx - tt * 160, m = m0 + tt;
            const float zc = bf2f(Z[(size_t)m * NZ + ZLOW + i]); const float zp = ((m & (SEQ - 1)) == 0) ? 0.f : bf2f(Z[(size_t)(m - 1) * NZ + ZLOW + i]);
            float x = zc + mu[1536 + i] * (zp - zc);
            if (i < 32) x = tanhf(x); else if (i >= 64) x = sigmoidf(x);
            low[idx] = x; }
        __syncthreads();
        float zrp, zkp;
        if ((m0 & (SEQ - 1)) == 0) { zrp = 0.f; zkp = 0.f; }
        else { zrp = bf2f(Z[(size_t)(m0 - 1) * NZ + ZRR + c]); zkp = bf2f(Z[(size_t)(m0 - 1) * NZ + ZRK + c]); }
#pragma unroll 1
        for (int tt = 0; tt < 32; ++tt) { const int m = m0 + tt;
            const float zr = bf2f(Z[(size_t)m * NZ + ZRR + c]), zk = bf2f(Z[(size_t)m * NZ + ZRK + c]);
            const float r = zr + mur * (zrp - zr), k = zk + muk * (zkp - zk); zrp = zr; zkp = zk;
            const LAS float* lw = low + tt * 160;
            float wa = w0c, aa = a0c, ga = 0.f;
#pragma unroll
            for (int i = 0; i < 32; ++i) { wa += lw[i] * w2c[i]; aa += lw[32 + i] * a2c[i]; }
#pragma unroll
            for (int i = 0; i < 96; ++i) ga += lw[64 + i] * g2c[i];
            const float nw = -wa;
            const float sp = fmaxf(nw, 0.f) + log1pf(expf(-fabsf(nw)));
            const float dec = expf(-expf(-sp - 0.5f));
            const float a = sigmoidf(aa);
            float kk = k * kkc; const float ssq = wave_sum(kk * kk); kk = kk / fmaxf(sqrtf(ssq), 1e-12f);
            const float kf = k * (1.0f + (a - 1.0f) * kac);
            const float bon = wave_sum(r * kf * rkc);
            const size_t o = (size_t)m * 512 + c;
            DEC[o] = dec; KF[o] = (bf16)f2bf(kf); KK[o] = (bf16)f2bf(kk); BB[o] = (bf16)f2bf(kk * a); GG[o] = (bf16)f2bf(ga);
            if (lane == 0) BON[(size_t)m * 8 + wave] = bon; }
        __syncthreads();
    }
}
__device__ __forceinline__ void gla_pre(const Ptrs& P, LAS unsigned char* lds, int tid, int lane, int wave) {
    unsigned char* ws = P.ws;
    const bf16* Z = (const bf16*)(ws + WS_Z);
    bf16 *QT = (bf16*)((unsigned char*)P.out + DO_QT), *KT = (bf16*)((unsigned char*)P.out + DO_KT), *KDT = (bf16*)((unsigned char*)P.out + DO_KDT), *VT = (bf16*)(ws + WS_VT);
    float* EL = (float*)(ws + WS_EL);
    LAS float* bbuf = (LAS float*)lds;
    const float* cwp = P.in[I_CONVW];
    for (int item = blockIdx.x; item < NB * 32; item += gridDim.x) {
        const int b = item >> 5, c = item & 31, mbase = b * SEQ + c * 64;
        if (tid < 256) { const int d = tid; float gkw[16];
#pragma unroll
            for (int i = 0; i < 16; ++i) gkw[i] = P.in[I_GKW][i * 256 + d];
            const float gkb = P.in[I_GKB][d]; float bc = 0.f;
#pragma unroll 1
            for (int t = 0; t < 64; ++t) { const bf16* zr = Z + (size_t)(mbase + t) * NZ + ZGK; float pre = gkb;
#pragma unroll
                for (int i = 0; i < 16; ++i) pre += bf2f(zr[i]) * gkw[i];
                const float ls = fminf(pre, 0.f) - log1pf(expf(-fabsf(pre)));
                bc += ls * (1.0f / 16.0f); bbuf[t * 256 + d] = bc; }
            EL[(size_t)(((b * 4 + (d >> 6)) * 32 + c) * 64) + (d & 63)] = expf(bc); }
        __syncthreads();
#pragma unroll 1
        for (int rep = 0; rep < 2; ++rep) { const int ch = tid + 512 * rep;
            const float cw0 = cwp[ch], cw1 = cwp[1024 + ch], cw2 = cwp[2048 + ch], cw3 = cwp[3072 + ch];
            float x3 = 0.f, x2 = 0.f, x1 = 0.f;
            if (c > 0) { x3 = bf2f(Z[(size_t)(mbase - 3) * NZ + ch]); x2 = bf2f(Z[(size_t)(mbase - 2) * NZ + ch]); x1 = bf2f(Z[(size_t)(mbase - 1) * NZ + ch]); }
            const int d = ch & 255, hq = d >> 6, dk = d & 63;
            const size_t tile = (size_t)((b * 4 + hq) * 32 + c) * 4096;
            const float blast = bbuf[63 * 256 + d];
            const int e = ch - 512, hv = e >> 7, dv = e & 127;
            const size_t vtile = (size_t)((b * 4 + hv) * 32 + c) * 8192;
#pragma unroll 1
            for (int t = 0; t < 64; ++t) { const float x = bf2f(Z[(size_t)(mbase + t) * NZ + ch]);
                const float y = cw0 * x3 + cw1 * x2 + cw2 * x1 + cw3 * x; x3 = x2; x2 = x1; x1 = x;
                const float s = y / (1.0f + expf(-y));
                if (ch < 256) { const float bt = bbuf[t * 256 + d]; QT[tile + t * 64 + dk] = (bf16)f2bf(s * 0.125f * expf(bt)); }
                else if (ch < 512) { const float bt = bbuf[t * 256 + d]; KT[tile + t * 64 + dk] = (bf16)f2bf(s * expf(-bt)); KDT[tile + dk * 64 + t] = (bf16)f2bf(s * expf(blast - bt)); }
                else { VT[vtile + dv * 64 + t] = (bf16)f2bf(s); } } }
        __syncthreads();
    }
}

__device__ __forceinline__ float fast_tanh(float x) { return 1.0f - 2.0f / (__expf(2.0f * x) + 1.0f); }
__device__ __forceinline__ float fast_sigmoid(float x) { return 1.0f / (1.0f + __expf(-x)); }
__device__ __forceinline__ void rwkv_pre2(const Ptrs& P, LAS unsigned char* lds, int tid, int lane, int wave) {
    using pg8::bf16x8; using pg8::f32x4; using pg8::bflo; using pg8::bfhi;
    constexpr int TT = 64, LP = 336, OFF_C = TT * LP;
    unsigned char* ws = P.ws;
    const bf16* Z = (const bf16*)(ws + WS_Z);
    float* DEC = (float*)((unsigned char*)P.out + DO_DEC);
    bf16 *KF = (bf16*)(ws + WS_KF), *KK = (bf16*)(ws + WS_KK), *BB = (bf16*)(ws + WS_BB), *GG = (bf16*)(ws + WS_GG);
    float* BON = (float*)(ws + WS_BON);
    const float* mu = P.in[I_MU];
    const bf16* LWT = (const bf16*)(ws + WS_LWT);
    const int fr = lane & 15, fq = lane >> 4;
    LAS float* cst = (LAS float*)(lds + OFF_C);
    { const int i = tid; cst[i] = P.in[I_W0][i]; cst[512 + i] = P.in[I_A0][i]; cst[1024 + i] = P.in[I_KK][i]; cst[1536 + i] = P.in[I_KA][i]; cst[2048 + i] = P.in[I_RK][i]; cst[2560 + i] = mu[i]; cst[3072 + i] = mu[512 + i]; }
    __syncthreads();
    for (int item = blockIdx.x; item < M / TT; item += gridDim.x) {
        const int m0 = item * TT;
#pragma unroll 2
        for (int j = 0; j < 10; ++j) { const int pidx = tid + 512 * j, tt = pidx / 80, i = 2 * (pidx - tt * 80), m = m0 + tt;
            const unsigned zc = *(const unsigned*)(Z + (size_t)m * NZ + ZLOW + i); const unsigned zp = ((m & (SEQ - 1)) == 0) ? 0u : *(const unsigned*)(Z + (size_t)(m - 1) * NZ + ZLOW + i);
            float x0 = bflo(zc) + mu[1536 + i] * (bflo(zp) - bflo(zc)), x1 = bfhi(zc) + mu[1537 + i] * (bfhi(zp) - bfhi(zc));
            if (i < 32) { x0 = fast_tanh(x0); x1 = fast_tanh(x1); } else if (i >= 64) { x0 = fast_sigmoid(x0); x1 = fast_sigmoid(x1); }
            *(LAS unsigned*)(lds + tt * LP + i * 2) = pk2(x0, x1); }
        __syncthreads();
        bf16x8 wfa[4][2];
#pragma unroll
        for (int mt = 0; mt < 4; ++mt)
#pragma unroll
            for (int ks = 0; ks < 2; ++ks) wfa[mt][ks] = *(const bf16x8*)(LWT + (size_t)(64 * wave + 16 * mt + fr) * 160 + 32 * ks + 8 * fq);
#pragma unroll 1
        for (int tile = 0; tile < TT / 16; ++tile) {
            bf16x8 bl[2];
#pragma unroll
            for (int ks = 0; ks < 2; ++ks) bl[ks] = *(const LAS bf16x8*)(lds + (tile * 16 + fr) * LP + (32 * ks + 8 * fq) * 2);
            const int m = m0 + tile * 16 + fr; const bool first = (m & (SEQ - 1)) == 0;
            float ssq = 0.f, bon = 0.f; f32x4 kkv[4], av[4];
#pragma unroll
            for (int mt = 0; mt < 4; ++mt) { const int c0 = 64 * wave + 16 * mt + 4 * fq;
                const f32x4 z4 = {0.f, 0.f, 0.f, 0.f};
                const f32x4 Dw_ = __builtin_amdgcn_mfma_f32_16x16x32_bf16(wfa[mt][0], bl[0], z4, 0, 0, 0);
                const f32x4 Da_ = __builtin_amdgcn_mfma_f32_16x16x32_bf16(wfa[mt][1], bl[1], z4, 0, 0, 0);
                const v2u zr = *(const v2u*)(Z + (size_t)m * NZ + ZRR + c0), zk = *(const v2u*)(Z + (size_t)m * NZ + ZRK + c0);
                v2u zrp = {0u, 0u}, zkp = {0u, 0u};
                if (!first) { zrp = *(const v2u*)(Z + (size_t)(m - 1) * NZ + ZRR + c0); zkp = *(const v2u*)(Z + (size_t)(m - 1) * NZ + ZRK + c0); }
                const f32x4 w0 = *(const LAS f32x4*)(cst + c0), a0 = *(const LAS f32x4*)(cst + 512 + c0), kkc = *(const LAS f32x4*)(cst + 1024 + c0), kac = *(const LAS f32x4*)(cst + 1536 + c0),
                            rkc = *(const LAS f32x4*)(cst + 2048 + c0), mur = *(const LAS f32x4*)(cst + 2560 + c0), muk = *(const LAS f32x4*)(cst + 3072 + c0);
                const f32x4 zr4 = {bflo(zr.x), bfhi(zr.x), bflo(zr.y), bfhi(zr.y)}, zrp4 = {bflo(zrp.x), bfhi(zrp.x), bflo(zrp.y), bfhi(zrp.y)};
                const f32x4 zk4 = {bflo(zk.x), bfhi(zk.x), bflo(zk.y), bfhi(zk.y)}, zkp4 = {bflo(zkp.x), bfhi(zkp.x), bflo(zkp.y), bfhi(zkp.y)};
                const f32x4 r4 = zr4 + mur * (zrp4 - zr4), k4 = zk4 + muk * (zkp4 - zk4);
                f32x4 dec, kf, a4;
#pragma unroll
                for (int e = 0; e < 4; ++e) { const float nw = -(w0[e] + Dw_[e]);
                    const float sp = fmaxf(nw, 0.f) + __logf(1.0f + __expf(-fabsf(nw)));
                    dec[e] = __expf(-__expf(-sp - 0.5f));
                    a4[e] = fast_sigmoid(a0[e] + Da_[e]); }
                const f32x4 kk = k4 * kkc; kf = k4 * (1.0f + (a4 - 1.0f) * kac);
                ssq += (kk[0] * kk[0] + kk[1] * kk[1]) + (kk[2] * kk[2] + kk[3] * kk[3]);
                { const f32x4 t = r4 * kf * rkc; bon += (t[0] + t[1]) + (t[2] + t[3]); }
                kkv[mt] = kk; av[mt] = a4;
                const size_t o = (size_t)m * 512 + c0;
                *(f32x4*)(DEC + o) = dec;
                { v2u w; w.x = pk2(kf[0], kf[1]); w.y = pk2(kf[2], kf[3]); *(v2u*)(KF + o) = w; }
                asm volatile("" ::: "memory"); }
            ssq += __shfl_xor(ssq, 16); ssq += __shfl_xor(ssq, 32); bon += __shfl_xor(bon, 16); bon += __shfl_xor(bon, 32);
            const float inv = 1.0f / fmaxf(sqrtf(ssq), 1e-12f);
#pragma unroll
            for (int mt = 0; mt < 4; ++mt) { const int c0 = 64 * wave + 16 * mt + 4 * fq; const size_t o = (size_t)m * 512 + c0;
                const f32x4 kn = kkv[mt] * inv, bb = kn * av[mt];
                { v2u w; w.x = pk2(kn[0], kn[1]); w.y = pk2(kn[2], kn[3]); *(v2u*)(KK + o) = w; }
                { v2u w; w.x = pk2(bb[0], bb[1]); w.y = pk2(bb[2], bb[3]); *(v2u*)(BB + o) = w; } }
            if (fq == 0) BON[(size_t)m * 8 + wave] = bon;
        }
        {
            bf16x8 wfb[4][3];
#pragma unroll
            for (int mt = 0; mt < 4; ++mt)
#pragma unroll
                for (int ks = 0; ks < 3; ++ks) wfb[mt][ks] = *(const bf16x8*)(LWT + (size_t)(64 * wave + 16 * mt + fr) * 160 + 64 + 32 * ks + 8 * fq);
#pragma unroll 1
            for (int tile = 0; tile < TT / 16; ++tile) { const int m = m0 + tile * 16 + fr;
                bf16x8 bl[3];
#pragma unroll
                for (int ks = 0; ks < 3; ++ks) bl[ks] = *(const LAS bf16x8*)(lds + (tile * 16 + fr) * LP + (64 + 32 * ks + 8 * fq) * 2);
#pragma unroll
                for (int mt = 0; mt < 4; ++mt) { f32x4 g = {0.f, 0.f, 0.f, 0.f};
                    g = __builtin_amdgcn_mfma_f32_16x16x32_bf16(wfb[mt][0], bl[0], g, 0, 0, 0);
                    g = __builtin_amdgcn_mfma_f32_16x16x32_bf16(wfb[mt][1], bl[1], g, 0, 0, 0);
                    g = __builtin_amdgcn_mfma_f32_16x16x32_bf16(wfb[mt][2], bl[2], g, 0, 0, 0);
                    v2u w; w.x = pk2(g[0], g[1]); w.y = pk2(g[2], g[3]); *(v2u*)(GG + (size_t)m * 512 + 64 * wave + 16 * mt + 4 * fq) = w; } } }
        __syncthreads();
    }
}
__device__ __forceinline__ void gla_pre2(const Ptrs& P, LAS unsigned char* lds, int tid, int lane, int wave) {
    unsigned char* ws = P.ws;
    const bf16* __restrict__ Z = (const bf16*)(ws + WS_Z);
    bf16 *QT = (bf16*)((unsigned char*)P.out + DO_QT), *KT = (bf16*)((unsigned char*)P.out + DO_KT), *KDT = (bf16*)((unsigned char*)P.out + DO_KDT), *VT = (bf16*)(ws + WS_VT);
    float* EL = (float*)(ws + WS_EL);
    LAS float* bbuf = (LAS float*)lds;
    LAS float* gl = (LAS float*)(lds + 65536);
    const float* cwp = P.in[I_CONVW];
    for (int item = blockIdx.x; item < NB * 32; item += gridDim.x) {
        const int b = item >> 5, c = item & 31, mbase = b * SEQ + c * 64;
        { const int idx = tid * 2, t = idx >> 4, i = idx & 15; const unsigned z2 = *(const unsigned*)(Z + (size_t)(mbase + t) * NZ + ZGK + i); gl[idx] = pg8::bflo(z2); gl[idx + 1] = pg8::bfhi(z2); }
        __syncthreads();
        if (tid < 256) { const int d = tid; float gkw[16];
#pragma unroll
            for (int i = 0; i < 16; ++i) gkw[i] = P.in[I_GKW][i * 256 + d];
            const float gkb = P.in[I_GKB][d]; float bc = 0.f;
#pragma unroll 4
            for (int t = 0; t < 64; ++t) { float pre = gkb;
#pragma unroll
                for (int i = 0; i < 16; ++i) pre += gl[t * 16 + i] * gkw[i];
                const float ls = fminf(pre, 0.f) - __logf(1.0f + __expf(-fabsf(pre)));
                bc += ls * (1.0f / 16.0f); bbuf[t * 256 + d] = bc; }
            EL[(size_t)(((b * 4 + (d >> 6)) * 32 + c) * 64) + (d & 63)] = __expf(bc); }
        __syncthreads();
#pragma unroll 1
        for (int rep = 0; rep < 2; ++rep) { const int ch = tid + 512 * rep;
            const float cw0 = cwp[ch], cw1 = cwp[1024 + ch], cw2 = cwp[2048 + ch], cw3 = cwp[3072 + ch];
            float x3 = 0.f, x2 = 0.f, x1 = 0.f;
            if (c > 0) { x3 = bf2f(Z[(size_t)(mbase - 3) * NZ + ch]); x2 = bf2f(Z[(size_t)(mbase - 2) * NZ + ch]); x1 = bf2f(Z[(size_t)(mbase - 1) * NZ + ch]); }
            const int d = ch & 255, hq = d >> 6, dk = d & 63;
            const size_t tile = (size_t)((b * 4 + hq) * 32 + c) * 4096;
            const float blast = bbuf[63 * 256 + d];
            const int e = ch - 512, hv = e >> 7, dv = e & 127;
            const size_t vtile = (size_t)((b * 4 + hv) * 32 + c) * 8192;
            unsigned short xr[8], xn_[8];
#pragma unroll
            for (int u = 0; u < 8; ++u) xr[u] = Z[(size_t)(mbase + u) * NZ + ch];
#pragma unroll 1
            for (int t0 = 0; t0 < 64; t0 += 8) {
                if (t0 + 8 < 64) {
#pragma unroll
                    for (int u = 0; u < 8; ++u) xn_[u] = Z[(size_t)(mbase + t0 + 8 + u) * NZ + ch]; }
                float sv[8];
#pragma unroll
                for (int u = 0; u < 8; ++u) { const float x = bf2f(xr[u]); const float y = cw0 * x3 + cw1 * x2 + cw2 * x1 + cw3 * x; x3 = x2; x2 = x1; x1 = x; sv[u] = y / (1.0f + __expf(-y)); }
                if (ch < 256) {
#pragma unroll
                    for (int u = 0; u < 8; ++u) { const float bt = bbuf[(t0 + u) * 256 + d]; QT[tile + (t0 + u) * 64 + dk] = (bf16)f2bf(sv[u] * 0.125f * __expf(bt)); } }
                else if (ch < 512) { v4u kd;
#pragma unroll
                    for (int u = 0; u < 8; ++u) { const float bt = bbuf[(t0 + u) * 256 + d]; KT[tile + (t0 + u) * 64 + dk] = (bf16)f2bf(sv[u] * __expf(-bt)); sv[u] = sv[u] * __expf(blast - bt); }
                    kd.x = pk2(sv[0], sv[1]); kd.y = pk2(sv[2], sv[3]); kd.z = pk2(sv[4], sv[5]); kd.w = pk2(sv[6], sv[7]);
                    *(v4u*)(KDT + tile + dk * 64 + t0) = kd; }
                else { v4u vv; vv.x = pk2(sv[0], sv[1]); vv.y = pk2(sv[2], sv[3]); vv.z = pk2(sv[4], sv[5]); vv.w = pk2(sv[6], sv[7]);
                    *(v4u*)(VT + vtile + dv * 64 + t0) = vv; }
#pragma unroll
                for (int u = 0; u < 8; ++u) xr[u] = xn_[u]; } }
        __syncthreads();
    }
}

__device__ __forceinline__ void rwkv_scan_naive(const Ptrs& P, LAS unsigned char* lds, int lane, int bh) {
    unsigned char* ws = P.ws;
    const bf16* Z = (const bf16*)(ws + WS_Z);
    const float* DEC = (const float*)((unsigned char*)P.out + DO_DEC);
    const bf16 *KF = (const bf16*)(ws + WS_KF), *KK = (const bf16*)(ws + WS_KK), *BB = (const bf16*)(ws + WS_BB), *GG = (const bf16*)(ws + WS_GG);
    const float* BON = (const float*)(ws + WS_BON);
    bf16* OCAT = (bf16*)(ws + WS_OCAT);
    const int b = bh >> 3, h = bh & 7, ch = h * 64 + lane;
    const float mur = P.in[I_MU][ch], muv = P.in[I_MU][1024 + ch], gnw = P.in[I_GNW][ch], gnb = P.in[I_GNB][ch];
    LAS float* vec = (LAS float*)lds;
    float s[64];
#pragma unroll
    for (int j = 0; j < 64; ++j) s[j] = 0.f;
    float zrp = 0.f, zvp = 0.f;
#pragma unroll 1
    for (int t0 = 0; t0 < SEQ; t0 += 16) {
#pragma unroll 4
        for (int tt = 0; tt < 16; ++tt) { const size_t m = (size_t)b * SEQ + t0 + tt;
            const float zr = bf2f(Z[m * NZ + ZRR + ch]), zv = bf2f(Z[m * NZ + ZRV + ch]);
            const float r = zr + mur * (zrp - zr), v = zv + muv * (zvp - zv); zrp = zr; zvp = zv;
            LAS float* vp = vec + tt * 384 + lane;
            vp[0] = DEC[m * 512 + ch]; vp[64] = -bf2f(KK[m * 512 + ch]); vp[128] = bf2f(BB[m * 512 + ch]); vp[192] = bf2f(KF[m * 512 + ch]); vp[256] = r; vp[320] = v; }
        LDS_WAIT(); asm volatile("" ::: "memory");
#pragma unroll 1
        for (int tt = 0; tt < 16; ++tt) { const size_t m = (size_t)b * SEQ + t0 + tt;
            const LAS float* vp = vec + tt * 384;
            const float v = vp[320 + lane];
            float sa = 0.f;
#pragma unroll
            for (int j = 0; j < 64; ++j) sa += s[j] * vp[64 + j];
            float y = 0.f;
#pragma unroll
            for (int j = 0; j < 64; ++j) { s[j] = s[j] * vp[j] + (sa * vp[128 + j] + v * vp[192 + j]); y += s[j] * vp[256 + j]; }
            const float mean = wave_sum(y) * (1.0f / 64.0f), dlt = y - mean;
            const float var = wave_sum(dlt * dlt) * (1.0f / 64.0f);
            float yn = dlt * (1.0f / sqrtf(var + 64e-5f)) * gnw + gnb;
            yn += BON[m * 8 + h] * v;
            OCAT[m * 1024 + 512 + ch] = (bf16)f2bf(yn * bf2f(GG[m * 512 + ch])); }
        LDS_WAIT(); asm volatile("" ::: "memory");
    }
}
__device__ __forceinline__ void gla_scan_naive(const Ptrs& P, int lane, int bh) {
    unsigned char* ws = P.ws;
    const bf16* Z = (const bf16*)(ws + WS_Z);
    const bf16 *QT = (const bf16*)((unsigned char*)P.out + DO_QT), *KT = (const bf16*)((unsigned char*)P.out + DO_KT), *VT = (const bf16*)(ws + WS_VT);
    const float* EL = (const float*)(ws + WS_EL);
    bf16* OCAT = (bf16*)(ws + WS_OCAT);
    const int b = bh >> 2, h = bh & 3;
    const float ng0 = P.in[I_NORMG][lane], ng1 = P.in[I_NORMG][64 + lane];
    float U0[64], U1[64];
#pragma unroll
    for (int d = 0; d < 64; ++d) { U0[d] = 0.f; U1[d] = 0.f; }
#pragma unroll 1
    for (int c = 0; c < 32; ++c) { const size_t tl = (size_t)(bh * 32 + c);
        const bf16 *qt = QT + tl * 4096, *kt = KT + tl * 4096, *vt = VT + tl * 8192;
#pragma unroll 1
        for (int t = 0; t < 64; ++t) { const size_t m = (size_t)b * SEQ + c * 64 + t;
            const float v0 = bf2f(vt[lane * 64 + t]), v1 = bf2f(vt[(64 + lane) * 64 + t]);
            float o0 = 0.f, o1 = 0.f;
#pragma unroll
            for (int d = 0; d < 64; ++d) { const float kd = bf2f(kt[t * 64 + d]), qd = bf2f(qt[t * 64 + d]);
                U0[d] += kd * v0; U1[d] += kd * v1; o0 += qd * U0[d]; o1 += qd * U1[d]; }
            const float rstd = 1.0f / sqrtf(wave_sum(o0 * o0 + o1 * o1) * (1.0f / 128.0f) + EPS);
            const float g0 = bf2f(Z[m * NZ + ZG + h * 128 + lane]), g1 = bf2f(Z[m * NZ + ZG + h * 128 + 64 + lane]);
            OCAT[m * 1024 + h * 128 + lane] = (bf16)f2bf(o0 * rstd * ng0 * (g0 / (1.0f + expf(-g0))));
            OCAT[m * 1024 + h * 128 + 64 + lane] = (bf16)f2bf(o1 * rstd * ng1 * (g1 / (1.0f + expf(-g1)))); }
        const float* el = EL + tl * 64;
#pragma unroll
        for (int d = 0; d < 64; ++d) { const float e = el[d]; U0[d] *= e; U1[d] *= e; } }
}


__device__ __forceinline__ float dpp_f(float x, const int ctrl_sel) {
    int r;
    const int xi = __float_as_int(x);
    switch (ctrl_sel) {
        case 0: r = __builtin_amdgcn_update_dpp(0, xi, 0xB1, 0xF, 0xF, true); break;
        case 1: r = __builtin_amdgcn_update_dpp(0, xi, 0x4E, 0xF, 0xF, true); break;
        case 2: r = __builtin_amdgcn_update_dpp(0, xi, 0x141, 0xF, 0xF, true); break;
        default: r = __builtin_amdgcn_update_dpp(0, xi, 0x140, 0xF, 0xF, true); break;
    }
    return __int_as_float(r);
}
__device__ __forceinline__ float allreduce16(float x) { x += dpp_f(x, 0); x += dpp_f(x, 1); x += dpp_f(x, 2); x += dpp_f(x, 3); return x; }
typedef float f32x2v __attribute__((ext_vector_type(2)));
__device__ __forceinline__ float afma(float a, float b, float c) { float d; asm("v_fma_f32 %0, %1, %2, %3" : "=v"(d) : "v"(a), "v"(b), "v"(c)); return d; }
__device__ __forceinline__ float amul(float a, float b) { float d; asm("v_mul_f32 %0, %1, %2" : "=v"(d) : "v"(a), "v"(b)); return d; }
__device__ __forceinline__ void allreduce16x2(float& a, float& b) {
    asm volatile("s_nop 1\n\t"
                 "v_add_f32_dpp %0, %0, %0 quad_perm:[1,0,3,2] row_mask:0xf bank_mask:0xf bound_ctrl:1\n\t"
                 "v_add_f32_dpp %1, %1, %1 quad_perm:[1,0,3,2] row_mask:0xf bank_mask:0xf bound_ctrl:1\n\t"
                 "s_nop 0\n\t"
                 "v_add_f32_dpp %0, %0, %0 quad_perm:[2,3,0,1] row_mask:0xf bank_mask:0xf bound_ctrl:1\n\t"
                 "v_add_f32_dpp %1, %1, %1 quad_perm:[2,3,0,1] row_mask:0xf bank_mask:0xf bound_ctrl:1\n\t"
                 "s_nop 0\n\t"
                 "v_add_f32_dpp %0, %0, %0 row_half_mirror row_mask:0xf bank_mask:0xf bound_ctrl:1\n\t"
                 "v_add_f32_dpp %1, %1, %1 row_half_mirror row_mask:0xf bank_mask:0xf bound_ctrl:1\n\t"
                 "s_nop 0\n\t"
                 "v_add_f32_dpp %0, %0, %0 row_mirror row_mask:0xf bank_mask:0xf bound_ctrl:1\n\t"
                 "v_add_f32_dpp %1, %1, %1 row_mirror row_mask:0xf bank_mask:0xf bound_ctrl:1"
                 : "+v"(a), "+v"(b));
}

__device__ __forceinline__ void rwkv_scan(const Ptrs& P, LAS unsigned char* lds, int tid, int lane, int wave, int bh) {
    using pg8::f32x4;
    constexpr int TC = 32, NCH = SEQ / TC;
    unsigned char* ws = P.ws;
    const bf16* Z = (const bf16*)(ws + WS_Z);
    const float* DEC = (const float*)((unsigned char*)P.out + DO_DEC);
    const bf16 *KF = (const bf16*)(ws + WS_KF), *KK = (const bf16*)(ws + WS_KK), *BB = (const bf16*)(ws + WS_BB), *GG = (const bf16*)(ws + WS_GG);
    const float* BON = (const float*)(ws + WS_BON);
    bf16* OCAT = (bf16*)(ws + WS_OCAT);
    LAS float* bufs = (LAS float*)lds;
    LAS float* ybuf = bufs + 2 * TC * 384;
    const int b = bh >> 3, h = bh & 7;
    const int st_t = tid >> 4, st_c = tid & 15, st_ch = h * 64 + 4 * st_c;
    const f32x4 mur4 = *(const f32x4*)(P.in[I_MU] + st_ch), muv4 = *(const f32x4*)(P.in[I_MU] + 1024 + st_ch);
    const int p = lane & 15, q = lane >> 4, i0 = wave * 8 + 2 * q;
    const int pch = h * 64 + lane;
    const float gnw = P.in[I_GNW][pch], gnb = P.in[I_GNB][pch];
    f32x4 s0 = {0.f, 0.f, 0.f, 0.f}, s1 = {0.f, 0.f, 0.f, 0.f};
    f32x4 g_dec; v2u g_kf, g_kk, g_bb, g_zr, g_zv, g_zrp, g_zvp; unsigned short g_gg[4]; float g_bon[4];
#define RW_LOAD(cidx) do { const size_t m_ = (size_t)b * SEQ + (size_t)(cidx) * TC + st_t; const size_t o_ = m_ * 512 + st_ch; \
        g_dec = *(const f32x4*)(DEC + o_); g_kf = *(const v2u*)(KF + o_); g_kk = *(const v2u*)(KK + o_); g_bb = *(const v2u*)(BB + o_); \
        g_zr = *(const v2u*)(Z + m_ * NZ + ZRR + st_ch); g_zv = *(const v2u*)(Z + m_ * NZ + ZRV + st_ch); \
        if (((cidx) * TC + st_t) == 0) { g_zrp = (v2u){0u, 0u}; g_zvp = (v2u){0u, 0u}; } \
        else { g_zrp = *(const v2u*)(Z + (m_ - 1) * NZ + ZRR + st_ch); g_zvp = *(const v2u*)(Z + (m_ - 1) * NZ + ZRV + st_ch); } } while (0)
#define RW_LOAD_POST(cidx) do { _Pragma("unroll") for (int k_ = 0; k_ < 4; ++k_) { const size_t m_ = (size_t)b * SEQ + (size_t)(cidx) * TC + wave * 4 + k_; \
        g_gg[k_] = GG[m_ * 512 + pch]; g_bon[k_] = BON[m_ * 8 + h]; } } while (0)
#define RW_WRITE(dst) do { LAS float* d_ = (dst) + st_t * 384 + 4 * st_c; \
        *(LAS f32x4*)(d_) = g_dec; \
        *(LAS f32x4*)(d_ + 64) = (f32x4){-pg8::bflo(g_kk.x), -pg8::bfhi(g_kk.x), -pg8::bflo(g_kk.y), -pg8::bfhi(g_kk.y)}; \
        *(LAS f32x4*)(d_ + 128) = (f32x4){pg8::bflo(g_bb.x), pg8::bfhi(g_bb.x), pg8::bflo(g_bb.y), pg8::bfhi(g_bb.y)}; \
        *(LAS f32x4*)(d_ + 192) = (f32x4){pg8::bflo(g_kf.x), pg8::bfhi(g_kf.x), pg8::bflo(g_kf.y), pg8::bfhi(g_kf.y)}; \
        { const f32x4 zr_ = {pg8::bflo(g_zr.x), pg8::bfhi(g_zr.x), pg8::bflo(g_zr.y), pg8::bfhi(g_zr.y)}, zp_ = {pg8::bflo(g_zrp.x), pg8::bfhi(g_zrp.x), pg8::bflo(g_zrp.y), pg8::bfhi(g_zrp.y)}; \
          *(LAS f32x4*)(d_ + 256) = zr_ + mur4 * (zp_ - zr_); } \
        { const f32x4 zv_ = {pg8::bflo(g_zv.x), pg8::bfhi(g_zv.x), pg8::bflo(g_zv.y), pg8::bfhi(g_zv.y)}, zp_ = {pg8::bflo(g_zvp.x), pg8::bfhi(g_zvp.x), pg8::bflo(g_zvp.y), pg8::bfhi(g_zvp.y)}; \
          *(LAS f32x4*)(d_ + 320) = zv_ + muv4 * (zp_ - zv_); } } while (0)
    RW_LOAD(0); RW_WRITE(bufs);
    __syncthreads();
#pragma unroll 1
    for (int c = 0; c < NCH; ++c) {
        LAS float* cur = bufs + (c & 1) * TC * 384; LAS float* nxt = bufs + ((c & 1) ^ 1) * TC * 384;
        if (c + 1 < NCH) RW_LOAD(c + 1);
        RW_LOAD_POST(c);
        {
            const LAS float* sp = cur + 4 * p; const LAS float* vp = cur + 320 + i0; LAS float* yp = ybuf + i0;
            f32x4 wA, aA, bA, kA, rA, wB, aB, bB, kB, rB; f32x2v vA, vB;
#define RW_LD(S, tt_) do { w##S = *(const LAS f32x4*)(sp + (tt_) * 384); a##S = *(const LAS f32x4*)(sp + (tt_) * 384 + 64); b##S = *(const LAS f32x4*)(sp + (tt_) * 384 + 128); \
                k##S = *(const LAS f32x4*)(sp + (tt_) * 384 + 192); r##S = *(const LAS f32x4*)(sp + (tt_) * 384 + 256); v##S = *(const LAS f32x2v*)(vp + (tt_) * 384); } while (0)
#define RW_STEP(S, tt_) do { \
                float sa0 = amul(s00, a##S[0]), sa1 = amul(s10, a##S[0]); \
                sa0 = afma(s01, a##S[1], sa0); sa1 = afma(s11, a##S[1], sa1); sa0 = afma(s02, a##S[2], sa0); sa1 = afma(s12, a##S[2], sa1); sa0 = afma(s03, a##S[3], sa0); sa1 = afma(s13, a##S[3], sa1); \
                const float c00 = amul(k##S[0], v##S.x), c01 = amul(k##S[1], v##S.x), c02 = amul(k##S[2], v##S.x), c03 = amul(k##S[3], v##S.x); \
                const float c10 = amul(k##S[0], v##S.y), c11 = amul(k##S[1], v##S.y), c12 = amul(k##S[2], v##S.y), c13 = amul(k##S[3], v##S.y); \
                allreduce16x2(sa0, sa1); \
                s00 = afma(s00, w##S[0], afma(b##S[0], sa0, c00)); s01 = afma(s01, w##S[1], afma(b##S[1], sa0, c01)); s02 = afma(s02, w##S[2], afma(b##S[2], sa0, c02)); s03 = afma(s03, w##S[3], afma(b##S[3], sa0, c03)); \
                s10 = afma(s10, w##S[0], afma(b##S[0], sa1, c10)); s11 = afma(s11, w##S[1], afma(b##S[1], sa1, c11)); s12 = afma(s12, w##S[2], afma(b##S[2], sa1, c12)); s13 = afma(s13, w##S[3], afma(b##S[3], sa1, c13)); \
                float y0 = amul(s00, r##S[0]), y1 = amul(s10, r##S[0]); \
                y0 = afma(s01, r##S[1], y0); y1 = afma(s11, r##S[1], y1); y0 = afma(s02, r##S[2], y0); y1 = afma(s12, r##S[2], y1); y0 = afma(s03, r##S[3], y0); y1 = afma(s13, r##S[3], y1); \
                allreduce16x2(y0, y1); \
                if (p == 0) *(LAS f32x2v*)(yp + (tt_) * 64) = (f32x2v){y0, y1}; } while (0)
            float s00 = s0[0], s01 = s0[1], s02 = s0[2], s03 = s0[3], s10 = s1[0], s11 = s1[1], s12 = s1[2], s13 = s1[3];
            RW_LD(A, 0);
#pragma unroll 2
            for (int tt = 0; tt < TC; tt += 2) {
                RW_LD(B, tt + 1);
                RW_STEP(A, tt);
                if (tt + 2 < TC) RW_LD(A, tt + 2);
                RW_STEP(B, tt + 1);
            }
            s0 = (f32x4){s00, s01, s02, s03}; s1 = (f32x4){s10, s11, s12, s13};
#undef RW_LD
#undef RW_STEP
        }
        __syncthreads();
#if (PROBE_DUP & 16)
#pragma unroll 1
        for (int rep_ = 0; rep_ < 2; ++rep_)
#endif
#pragma unroll
        for (int k_ = 0; k_ < 4; ++k_) { const int tt = wave * 4 + k_; const size_t m = (size_t)b * SEQ + (size_t)c * TC + tt;
            const float y = ybuf[tt * 64 + lane], v = cur[tt * 384 + 320 + lane];
            const float mean = wave_sum(y) * (1.0f / 64.0f), dl = y - mean;
            const float var = wave_sum(dl * dl) * (1.0f / 64.0f);
            float yn = dl * (1.0f / sqrtf(var + 64e-5f)) * gnw + gnb;
            yn += g_bon[k_] * v;
            OCAT[m * 1024 + 512 + pch] = (bf16)f2bf(yn * bf2f(g_gg[k_])); }
        if (c + 1 < NCH) RW_WRITE(nxt);
        __syncthreads();
    }
#undef RW_LOAD
#undef RW_LOAD_POST
#undef RW_WRITE
}


__device__ __forceinline__ void gla_scan(const Ptrs& P, LAS unsigned char* lds, int tid, int lane, int wave, int bh) {
    using pg8::bf16x8; using pg8::f32x4;
    constexpr int RS = 144, T64 = 64 * RS, T128 = 128 * RS;
    constexpr int OFF_QT = 0, OFF_KT = T64, OFF_KDT = 2 * T64, OFF_VT = 3 * T64, BUFSZ = 3 * T64 + T128;
    constexpr int OFF_P = 2 * BUFSZ, OFF_ST = OFF_P + 2 * T64, OFF_SS = OFF_ST + T128, OFF_GO = OFF_SS + 512, GOP = 272;
    static_assert(OFF_GO + 64 * GOP <= LDS_MISC, "gla LDS map");
    unsigned char* ws = P.ws;
    const bf16* Z = (const bf16*)(ws + WS_Z);
    const bf16 *QT = (const bf16*)((unsigned char*)P.out + DO_QT), *KT = (const bf16*)((unsigned char*)P.out + DO_KT), *KDT = (const bf16*)((unsigned char*)P.out + DO_KDT), *VT = (const bf16*)(ws + WS_VT);
    const float* EL = (const float*)(ws + WS_EL);
    bf16* OCAT = (bf16*)(ws + WS_OCAT);
    const int b = bh >> 2, h = bh & 3;
    const int fr = lane & 15, fq = lane >> 4, wr2 = wave >> 1, wc2 = wave & 1;
    const int st_row = tid >> 3, st_c = tid & 7;
    LAS float* SS = (LAS float*)(lds + OFF_SS);
    for (int i = tid; i < T128 / 16; i += 512) *(LAS v4u*)(lds + OFF_ST + i * 16) = (v4u){0u, 0u, 0u, 0u};
    float ng[4];
#pragma unroll
    for (int j = 0; j < 4; ++j) ng[j] = P.in[I_NORMG][(wc2 * 4 + j) * 16 + fr];
    f32x4 Sacc[4];
#pragma unroll
    for (int j = 0; j < 4; ++j) Sacc[j] = (f32x4){0.f, 0.f, 0.f, 0.f};
    v4u gA_q, gA_k, gA_kd, gA_v0, gA_v1, gB_q, gB_k, gB_kd, gB_v0, gB_v1; f32x4 elA, elB; unsigned short gzA[4][4], gzB[4][4];
#define GL_LOAD(S, cidx) do { const size_t tl_ = (size_t)(bh * 32 + (cidx)); const size_t o_ = tl_ * 4096 + st_row * 64 + st_c * 8; \
        g##S##_q = *(const v4u*)(QT + o_); g##S##_k = *(const v4u*)(KT + o_); g##S##_kd = *(const v4u*)(KDT + o_); \
        g##S##_v0 = *(const v4u*)(VT + tl_ * 8192 + st_row * 64 + st_c * 8); g##S##_v1 = *(const v4u*)(VT + tl_ * 8192 + (st_row + 64) * 64 + st_c * 8); } while (0)
#define GL_WRITE(S, bufoff) do { LAS unsigned char* d_ = lds + (bufoff) + st_row * RS + st_c * 16; \
        *(LAS v4u*)(d_ + OFF_QT) = g##S##_q; *(LAS v4u*)(d_ + OFF_KT) = g##S##_k; *(LAS v4u*)(d_ + OFF_KDT) = g##S##_kd; *(LAS v4u*)(d_ + OFF_VT) = g##S##_v0; *(LAS v4u*)(d_ + OFF_VT + 64 * RS) = g##S##_v1; } while (0)
#define GL_LOAD_AUX(S, cidx) do { const size_t tl_ = (size_t)(bh * 32 + (cidx)); const size_t mb_ = (size_t)b * SEQ + (size_t)(cidx) * 64; \
        el##S = *(const f32x4*)(EL + tl_ * 64 + wr2 * 16 + 4 * fq); \
        _Pragma("unroll") for (int j = 0; j < 4; ++j) _Pragma("unroll") for (int r = 0; r < 4; ++r) gz##S[j][r] = Z[(mb_ + wr2 * 16 + 4 * fq + r) * NZ + ZG + h * 128 + (wc2 * 4 + j) * 16 + fr]; } while (0)
#define FRAG(base, rblk, ks) (*(const LAS bf16x8*)((base) + ((rblk) * 16 + fr) * RS + ((ks) * 32 + fq * 8) * 2))
#define GL_S1(boff, pi) do { LAS unsigned char* bq_ = lds + (boff) + OFF_QT; LAS unsigned char* bk_ = lds + (boff) + OFF_KT; \
        const bf16x8 a0 = FRAG(bk_, wr2, 0), a1 = FRAG(bk_, wr2, 1); \
        _Pragma("unroll") for (int j = 0; j < 2; ++j) { const int tib = wc2 * 2 + j; f32x4 d = {0.f, 0.f, 0.f, 0.f}; \
            d = __builtin_amdgcn_mfma_f32_16x16x32_bf16(a0, FRAG(bq_, tib, 0), d, 0, 0, 0); d = __builtin_amdgcn_mfma_f32_16x16x32_bf16(a1, FRAG(bq_, tib, 1), d, 0, 0, 0); \
            const int ti = tib * 16 + fr, tj0 = wr2 * 16 + 4 * fq; \
            v2u w; w.x = pk2(ti >= tj0 ? d[0] : 0.f, ti >= tj0 + 1 ? d[1] : 0.f); w.y = pk2(ti >= tj0 + 2 ? d[2] : 0.f, ti >= tj0 + 3 ? d[3] : 0.f); \
            *(LAS v2u*)(lds + OFF_P + (pi) * T64 + ti * RS + tj0 * 2) = w; } } while (0)
    GL_LOAD(A, 0); GL_WRITE(A, 0); GL_LOAD(B, 1); GL_LOAD_AUX(A, 0);
    __syncthreads();
    GL_S1(0, 0);
    LDS_WAIT(); __syncthreads();
#define GL_ITER(c, LS, WS) do { \
        const int cur = ((c) & 1) * BUFSZ, nxt = (((c) & 1) ^ 1) * BUFSZ; \
        const size_t mbase = (size_t)b * SEQ + (size_t)(c) * 64; \
        if ((c) >= 1) { _Pragma("unroll") for (int q_ = 0; q_ < 2; ++q_) { const int id_ = tid + 512 * q_; const v4u o_ = *(const LAS v4u*)(lds + OFF_GO + (id_ >> 4) * GOP + (id_ & 15) * 16); \
            *(v4u*)(OCAT + (mbase - 64 + (id_ >> 4)) * 1024 + h * 128 + (id_ & 15) * 8) = o_; } } \
        if ((c) + 1 < 32) { GL_WRITE(WS, nxt); GL_LOAD_AUX(WS, (c) + 1); } \
        if ((c) + 2 < 32) GL_LOAD(LS, (c) + 2); \
        LAS unsigned char* bq = lds + cur + OFF_QT; LAS unsigned char* bk = lds + cur + OFF_KT; LAS unsigned char* bkd = lds + cur + OFF_KDT; LAS unsigned char* bv = lds + cur + OFF_VT; \
        f32x4 O[4]; \
        { const bf16x8 p0 = FRAG(lds + OFF_P + ((c) & 1) * T64, wr2, 0), p1 = FRAG(lds + OFF_P + ((c) & 1) * T64, wr2, 1), q0 = FRAG(bq, wr2, 0), q1 = FRAG(bq, wr2, 1); \
          _Pragma("unroll") for (int j = 0; j < 4; ++j) { const int ct = wc2 * 4 + j; f32x4 d = {0.f, 0.f, 0.f, 0.f}; \
            d = __builtin_amdgcn_mfma_f32_16x16x32_bf16(p0, FRAG(bv, ct, 0), d, 0, 0, 0); d = __builtin_amdgcn_mfma_f32_16x16x32_bf16(p1, FRAG(bv, ct, 1), d, 0, 0, 0); \
            d = __builtin_amdgcn_mfma_f32_16x16x32_bf16(q0, FRAG(lds + OFF_ST, ct, 0), d, 0, 0, 0); d = __builtin_amdgcn_mfma_f32_16x16x32_bf16(q1, FRAG(lds + OFF_ST, ct, 1), d, 0, 0, 0); \
            O[j] = d; } } \
        { const bf16x8 a0 = FRAG(bkd, wr2, 0), a1 = FRAG(bkd, wr2, 1); \
          _Pragma("unroll") for (int j = 0; j < 4; ++j) { const int ct = wc2 * 4 + j; f32x4 d = Sacc[j] * el##LS; \
            d = __builtin_amdgcn_mfma_f32_16x16x32_bf16(a0, FRAG(bv, ct, 0), d, 0, 0, 0); d = __builtin_amdgcn_mfma_f32_16x16x32_bf16(a1, FRAG(bv, ct, 1), d, 0, 0, 0); \
            Sacc[j] = d; } } \
        { f32x4 sq = {0.f, 0.f, 0.f, 0.f}; \
          _Pragma("unroll") for (int j = 0; j < 4; ++j) sq += O[j] * O[j]; \
          _Pragma("unroll") for (int r = 0; r < 4; ++r) { const float t = allreduce16(sq[r]); if (fr == 0) SS[(wr2 * 16 + 4 * fq + r) * 2 + wc2] = t; } } \
        LDS_WAIT(); __syncthreads(); \
        _Pragma("unroll") for (int j = 0; j < 4; ++j) { const int ct = wc2 * 4 + j; v2u w; w.x = pk2(Sacc[j][0], Sacc[j][1]); w.y = pk2(Sacc[j][2], Sacc[j][3]); \
            *(LAS v2u*)(lds + OFF_ST + (ct * 16 + fr) * RS + (wr2 * 16 + 4 * fq) * 2) = w; } \
        _Pragma("unroll") for (int r = 0; r < 4; ++r) { const int ti = wr2 * 16 + 4 * fq + r; const f32x2v s2 = *(const LAS f32x2v*)(SS + ti * 2); \
            const float rstd = 1.0f / sqrtf((s2.x + s2.y) * (1.0f / 128.0f) + EPS); \
            _Pragma("unroll") for (int j = 0; j < 4; ++j) { LAS bf16* gp_ = (LAS bf16*)(lds + OFF_GO + ti * GOP + ((wc2 * 4 + j) * 16 + fr) * 2); const float g = bf2f(gz##LS[j][r]); \
                *gp_ = (bf16)f2bf(O[j][r] * rstd * ng[j] * (g / (1.0f + __expf(-g)))); } } \
        if ((c) + 1 < 32) GL_S1(nxt, ((c) + 1) & 1); \
        LDS_WAIT(); __syncthreads(); } while (0)
#pragma unroll 1
    for (int c = 0; c < 32; c += 2) { GL_ITER(c, A, B); GL_ITER(c + 1, B, A); }
    { const size_t mb_ = (size_t)b * SEQ + 31 * 64;
#pragma unroll
      for (int q_ = 0; q_ < 2; ++q_) { const int id_ = tid + 512 * q_; const v4u o_ = *(const LAS v4u*)(lds + OFF_GO + (id_ >> 4) * GOP + (id_ & 15) * 16);
          *(v4u*)(OCAT + (mb_ + (id_ >> 4)) * 1024 + h * 128 + (id_ & 15) * 8) = o_; } }
#undef GL_ITER
#undef GL_LOAD_AUX
#undef GL_S1
#undef GL_LOAD
#undef GL_WRITE
#undef FRAG
}


constexpr size_t WS_GG2 = 77 * MiB;
constexpr size_t WS_QH = 381 * MiB, WS_GT = 413 * MiB, WS_LT = 445 * MiB, WS_VTT = 477 * MiB;
constexpr size_t DO_PM = 0;
__device__ __forceinline__ float dpp_shr(float x, const int n) {
    int r; const int xi = __float_as_int(x);
    switch (n) { case 1: r = __builtin_amdgcn_update_dpp(0, xi, 0x111, 0xF, 0xF, true); break; case 2: r = __builtin_amdgcn_update_dpp(0, xi, 0x112, 0xF, 0xF, true); break;
                 case 4: r = __builtin_amdgcn_update_dpp(0, xi, 0x114, 0xF, 0xF, true); break; default: r = __builtin_amdgcn_update_dpp(0, xi, 0x118, 0xF, 0xF, true); break; }
    return __int_as_float(r);
}

template <int I, int CS> __device__ __forceinline__ void fs_chunk(float (&x)[64], const float xi, const LAS unsigned char* nrow, const pg8::f32x4 (&cur)[2]) {
    pg8::f32x4 nxt[2];
    if constexpr (CS + 2 < 16) {
#pragma unroll
        for (int q = 0; q < 2; ++q) nxt[q] = *(const LAS pg8::f32x4*)(nrow + (CS + 2 + q) * 16); }
#pragma unroll
    for (int q = 0; q < 2; ++q)
#pragma unroll
        for (int e = 0; e < 4; ++e) if (4 * (CS + q) + e > I) x[4 * (CS + q) + e] += xi * cur[q][e];
    constexpr int q0 = 4 * CS;
    asm volatile("" : "+v"(x[q0]), "+v"(x[q0 + 1]), "+v"(x[q0 + 2]), "+v"(x[q0 + 3]), "+v"(x[q0 + 4]), "+v"(x[q0 + 5]), "+v"(x[q0 + 6]), "+v"(x[q0 + 7]) :: "memory");
    if constexpr (CS + 2 < 16) fs_chunk<I, CS + 2>(x, xi, nrow, nxt);
}
template <int I> __device__ __forceinline__ void fs_all(float (&x)[64], const LAS unsigned char* nabi) {
    constexpr int FPB = 68 * 4, G0 = ((I + 1) / 4) & ~1;
    const LAS unsigned char* nrow = nabi + I * FPB;
    pg8::f32x4 cur[2];
#pragma unroll
    for (int q = 0; q < 2; ++q) cur[q] = *(const LAS pg8::f32x4*)(nrow + (G0 + q) * 16);
    fs_chunk<I, G0>(x, x[I], nrow, cur);
    if constexpr (I + 1 < 63) fs_all<I + 1>(x, nabi);
}
template <int PK> __device__ __forceinline__ void rwa(const Ptrs& P, LAS unsigned char* lds, int tid, int lane, int wave) {
    using pg8::bf16x8; using pg8::f32x4; using pg8::bflo; using pg8::bfhi;
    constexpr int RS = 144, T64 = 64 * RS, LP = 336, FP = 68 * 4;
    constexpr int O_L = 0;
    constexpr int O_AT = 0, O_BT = T64, O_KT = 2 * T64, O_RT = 3 * T64, O_KH = 4 * T64, O_BHT = 5 * T64;
    constexpr int O_NABI = 6 * T64;
    constexpr int O_NAK = O_NABI + 64 * FP;
    constexpr int O_NBRT = O_NAK + 64 * FP;
    constexpr int O_AHT = O_NBRT + T64;
    constexpr int O_WM = O_AHT + T64;
    constexpr int O_MISC = O_WM + T64;
    constexpr int O_TBB = O_MISC + 4 * 256 * 4;
    static_assert(O_TBB + 4 * 1280 <= 131072 && O_L + 64 * LP <= O_NABI, "rwa LDS map");
    unsigned char* ws = P.ws;
    const bf16* Z = (const bf16*)(ws + WS_Z);
    bf16 *GG = (bf16*)(ws + WS_GG2), *QH = (bf16*)(ws + WS_QH), *GT = (bf16*)(ws + WS_GT), *LT = (bf16*)(ws + WS_LT), *VTT = (bf16*)(ws + WS_VTT);
    float* PM = (float*)((unsigned char*)P.out + DO_PM); float* BON = (float*)(ws + WS_BON);
    const float* mu = P.in[I_MU];
    const bf16* LWT = (const bf16*)(ws + WS_LWT);
    const int fr = lane & 15, fq = lane >> 4;
    LAS float* SSQ = (LAS float*)(lds + O_MISC); LAS float* BONP = SSQ + 256; LAS float* TOT = BONP + 256; LAS float* GC = TOT + 256;
    const int h = blockIdx.x & 7;
    const int mt = wave & 3, tt0 = 2 * (wave >> 2);
    const int c4 = 64 * h + 16 * mt + 4 * fq;
    for (int item = blockIdx.x; item < NB * 32 * 8; item += gridDim.x) {
        asm volatile("" ::: "memory");
        bf16x8 wf[5];
#pragma unroll
        for (int ks = 0; ks < 5; ++ks) wf[ks] = *(const bf16x8*)(LWT + (size_t)(64 * h + 16 * mt + fr) * 160 + 32 * ks + 8 * fq);
        const f32x4 w0 = *(const f32x4*)(P.in[I_W0] + c4), a0 = *(const f32x4*)(P.in[I_A0] + c4), kkc = *(const f32x4*)(P.in[I_KK] + c4), kac = *(const f32x4*)(P.in[I_KA] + c4),
                    rkc = *(const f32x4*)(P.in[I_RK] + c4), mur = *(const f32x4*)(mu + c4), muk = *(const f32x4*)(mu + 512 + c4), muv = *(const f32x4*)(mu + 1024 + c4);
        const int bc = item >> 3, b = bc >> 5, c = bc & 31; const int m0 = b * SEQ + c * 64;
        const size_t it4 = (size_t)((b * 8 + h) * 32 + c) * 4096;
#pragma unroll
        for (int half = 0; half < 2; ++half) { unsigned zcs[5], zps[5];
#pragma unroll
            for (int j = 0; j < 5; ++j) { const int pidx = tid + 512 * (5 * half + j), tt = pidx / 80, i = 2 * (pidx - tt * 80), m = m0 + tt;
                if (PK & 4) { zcs[j] = 0x3f803f80u + (unsigned)m; zps[j] = 0x3f003f00u; } else {
                zcs[j] = *(const unsigned*)(Z + (size_t)m * NZ + ZLOW + i); zps[j] = ((m & (SEQ - 1)) == 0) ? 0u : *(const unsigned*)(Z + (size_t)(m - 1) * NZ + ZLOW + i); } }
#pragma unroll
            for (int j = 0; j < 5; ++j) { const int pidx = tid + 512 * (5 * half + j), tt = pidx / 80, i = 2 * (pidx - tt * 80);
                const unsigned zc = zcs[j], zp = zps[j];
                float x0 = bflo(zc) + mu[1536 + i] * (bflo(zp) - bflo(zc)), x1 = bfhi(zc) + mu[1537 + i] * (bfhi(zp) - bfhi(zc));
                if (i < 32) { x0 = fast_tanh(x0); x1 = fast_tanh(x1); } else if (i >= 64) { x0 = fast_sigmoid(x0); x1 = fast_sigmoid(x1); }
                *(LAS unsigned*)(lds + O_L + tt * LP + i * 2) = pk2(x0, x1); }
            asm volatile("" ::: "memory"); }
        __syncthreads();
        f32x4 e_r[2], e_k[2], e_v[2], e_lw[2], e_kk[2], e_as[2];
#pragma unroll
        for (int u = 0; u < 2; ++u) { const int tt = tt0 + u, t = 16 * tt + fr, m = m0 + t;
            bf16x8 bl[5];
#pragma unroll
            for (int ks = 0; ks < 5; ++ks) bl[ks] = *(const LAS bf16x8*)(lds + O_L + t * LP + (32 * ks + 8 * fq) * 2);
            const f32x4 z4 = {0.f, 0.f, 0.f, 0.f};
            const f32x4 Dw = __builtin_amdgcn_mfma_f32_16x16x32_bf16(wf[0], bl[0], z4, 0, 0, 0);
            const f32x4 Da = __builtin_amdgcn_mfma_f32_16x16x32_bf16(wf[1], bl[1], z4, 0, 0, 0);
            f32x4 Dg = __builtin_amdgcn_mfma_f32_16x16x32_bf16(wf[2], bl[2], z4, 0, 0, 0);
            Dg = __builtin_amdgcn_mfma_f32_16x16x32_bf16(wf[3], bl[3], Dg, 0, 0, 0);
            Dg = __builtin_amdgcn_mfma_f32_16x16x32_bf16(wf[4], bl[4], Dg, 0, 0, 0);
            v2u zr = {0x3f803f80u, 0x3f003f00u}, zk = zr, zv = zr;
            if (!(PK & 8)) { zr = *(const v2u*)(Z + (size_t)m * NZ + ZRR + c4); zk = *(const v2u*)(Z + (size_t)m * NZ + ZRK + c4); zv = *(const v2u*)(Z + (size_t)m * NZ + ZRV + c4); }
            v2u zrp = {0u, 0u}, zkp = {0u, 0u}, zvp = {0u, 0u};
            if ((m & (SEQ - 1)) != 0 && !(PK & 8)) { zrp = *(const v2u*)(Z + (size_t)(m - 1) * NZ + ZRR + c4); zkp = *(const v2u*)(Z + (size_t)(m - 1) * NZ + ZRK + c4); zvp = *(const v2u*)(Z + (size_t)(m - 1) * NZ + ZRV + c4); }
            const f32x4 zr4 = {bflo(zr.x), bfhi(zr.x), bflo(zr.y), bfhi(zr.y)}, zrp4 = {bflo(zrp.x), bfhi(zrp.x), bflo(zrp.y), bfhi(zrp.y)};
            const f32x4 zk4 = {bflo(zk.x), bfhi(zk.x), bflo(zk.y), bfhi(zk.y)}, zkp4 = {bflo(zkp.x), bfhi(zkp.x), bflo(zkp.y), bfhi(zkp.y)};
            const f32x4 zv4 = {bflo(zv.x), bfhi(zv.x), bflo(zv.y), bfhi(zv.y)}, zvp4 = {bflo(zvp.x), bfhi(zvp.x), bflo(zvp.y), bfhi(zvp.y)};
            const f32x4 r4 = zr4 + mur * (zrp4 - zr4), k4 = zk4 + muk * (zkp4 - zk4), v4 = zv4 + muv * (zvp4 - zv4);
            f32x4 lw, as;
#pragma unroll
            for (int e = 0; e < 4; ++e) { const float nw = -(w0[e] + Dw[e]);
                const float sp = fmaxf(nw, 0.f) + __logf(1.0f + __expf(-fabsf(nw)));
                lw[e] = -__expf(-sp - 0.5f);
                as[e] = fast_sigmoid(a0[e] + Da[e]); }
            const f32x4 kk = k4 * kkc, kf = k4 * (1.0f + (as - 1.0f) * kac);
            float ssq = (kk[0] * kk[0] + kk[1] * kk[1]) + (kk[2] * kk[2] + kk[3] * kk[3]);
            float bon; { const f32x4 tb_ = r4 * kf * rkc; bon = (tb_[0] + tb_[1]) + (tb_[2] + tb_[3]); }
            ssq += __shfl_xor(ssq, 16); ssq += __shfl_xor(ssq, 32); bon += __shfl_xor(bon, 16); bon += __shfl_xor(bon, 32);
            if (fq == 0) { SSQ[t * 4 + mt] = ssq; BONP[t * 4 + mt] = bon; }
            { v2u w; w.x = pk2(Dg[0], Dg[1]); w.y = pk2(Dg[2], Dg[3]); if (PK == 0 || P.ws == nullptr) *(v2u*)(GG + (size_t)m * 512 + c4) = w; }
            e_r[u] = r4; e_k[u] = kf; e_v[u] = v4; e_lw[u] = lw; e_kk[u] = kk; e_as[u] = as; }
        f32x4 cum[2];
#pragma unroll
        for (int u = 0; u < 2; ++u) { f32x4 x = e_lw[u];
#pragma unroll
            for (int e = 0; e < 4; ++e) { float y = x[e]; y += dpp_shr(y, 1); y += dpp_shr(y, 2); y += dpp_shr(y, 4); y += dpp_shr(y, 8); x[e] = y; }
            cum[u] = x;
            if (fr == 15) *(LAS f32x4*)(TOT + (tt0 + u) * 64 + 16 * mt + 4 * fq) = x; }
        __syncthreads();
        f32x4 c63;
        { const LAS float* tp = TOT + 16 * mt + 4 * fq; const f32x4 t0_ = *(const LAS f32x4*)(tp), t1_ = *(const LAS f32x4*)(tp + 64), t2_ = *(const LAS f32x4*)(tp + 128), t3_ = *(const LAS f32x4*)(tp + 192);
          c63 = (t0_ + t1_) + (t2_ + t3_);
          f32x4 off0 = {0.f, 0.f, 0.f, 0.f}; if (tt0 == 2) off0 = t0_ + t1_;
          cum[0] = cum[0] + off0; cum[1] = cum[1] + off0 + (tt0 == 2 ? t2_ : t0_); }
        if (tt0 == 0 && fr == 0) *(LAS f32x4*)(GC + 16 * mt + 4 * fq) = (f32x4){__expf(c63[0]), __expf(c63[1]), __expf(c63[2]), __expf(c63[3])};
#pragma unroll
        for (int u = 0; u < 2; ++u) { const int tt = tt0 + u, t = 16 * tt + fr, m = m0 + t; const int j4 = 16 * mt + 4 * fq;
            const f32x4 sq = *(const LAS f32x4*)(SSQ + t * 4), bp = *(const LAS f32x4*)(BONP + t * 4);
            const float inv = 1.0f / fmaxf(sqrtf((sq[0] + sq[1]) + (sq[2] + sq[3])), 1e-12f);
            if (mt == 0 && fq == 0 && (PK == 0 || P.ws == nullptr)) BON[(size_t)m * 8 + h] = (bp[0] + bp[1]) + (bp[2] + bp[3]);
            const f32x4 kn = e_kk[u] * inv, av = -kn, bv = kn * e_as[u];
            f32x4 at, bt, kt, rt, kh, bh;
#pragma unroll
            for (int e = 0; e < 4; ++e) { const float cu = cum[u][e], ein = __expf(-cu), eg = __expf(cu), ee = __expf(c63[e] - cu);
                at[e] = av[e] * __expf(cu - e_lw[u][e]); bt[e] = bv[e] * ein; kt[e] = e_k[u][e] * ein; rt[e] = e_r[u][e] * eg; bh[e] = bv[e] * ee; kh[e] = e_k[u][e] * ee; }
            LAS unsigned char* tp = lds + t * RS + j4 * 2;
            { v2u w; w.x = pk2(at[0], at[1]); w.y = pk2(at[2], at[3]); *(LAS v2u*)(tp + O_AT) = w; }
            { v2u w; w.x = pk2(bt[0], bt[1]); w.y = pk2(bt[2], bt[3]); *(LAS v2u*)(tp + O_BT) = w; }
            { v2u w; w.x = pk2(kt[0], kt[1]); w.y = pk2(kt[2], kt[3]); *(LAS v2u*)(tp + O_KT) = w; }
            { v2u w; w.x = pk2(rt[0], rt[1]); w.y = pk2(rt[2], rt[3]); *(LAS v2u*)(tp + O_RT) = w; }
            { v2u w; w.x = pk2(kh[0], kh[1]); w.y = pk2(kh[2], kh[3]); *(LAS v2u*)(tp + O_KH) = w; }
#pragma unroll
            for (int e = 0; e < 4; ++e) { *(LAS bf16*)(lds + O_BHT + (j4 + e) * RS + t * 2) = (bf16)f2bf(bh[e]);
                if (PK == 0 || P.ws == nullptr) VTT[it4 + (size_t)(j4 + e) * 64 + t] = (bf16)f2bf(e_v[u][e]); } }
        __syncthreads();
        const int ib = wave >> 1, tb0 = 2 * (wave & 1);
        int fr3 = fr, fq3 = fq; asm volatile("" : "+v"(fr3), "+v"(fq3));
#define FRG(off, rblk, ks) (*(const LAS bf16x8*)(lds + (off) + ((rblk) * 16 + fr3) * RS + ((ks) * 32 + fq3 * 8) * 2))
        f32x4 nkr[2];
        { const bf16x8 b0 = FRG(O_BT, ib, 0), b1 = FRG(O_BT, ib, 1), k0 = FRG(O_KT, ib, 0), k1 = FRG(O_KT, ib, 1);
#pragma unroll
          for (int u = 0; u < 2; ++u) { const int tb = tb0 + u; const f32x4 z4 = {0.f, 0.f, 0.f, 0.f};
            const bf16x8 a0_ = FRG(O_AT, tb, 0), a1_ = FRG(O_AT, tb, 1), r0_ = FRG(O_RT, tb, 0), r1_ = FRG(O_RT, tb, 1);
            f32x4 dab = __builtin_amdgcn_mfma_f32_16x16x32_bf16(b0, a0_, z4, 0, 0, 0); dab = __builtin_amdgcn_mfma_f32_16x16x32_bf16(b1, a1_, dab, 0, 0, 0);
            f32x4 dak = __builtin_amdgcn_mfma_f32_16x16x32_bf16(k0, a0_, z4, 0, 0, 0); dak = __builtin_amdgcn_mfma_f32_16x16x32_bf16(k1, a1_, dak, 0, 0, 0);
            f32x4 dbr = __builtin_amdgcn_mfma_f32_16x16x32_bf16(b0, r0_, z4, 0, 0, 0); dbr = __builtin_amdgcn_mfma_f32_16x16x32_bf16(b1, r1_, dbr, 0, 0, 0);
            f32x4 dkr = __builtin_amdgcn_mfma_f32_16x16x32_bf16(k0, r0_, z4, 0, 0, 0); dkr = __builtin_amdgcn_mfma_f32_16x16x32_bf16(k1, r1_, dkr, 0, 0, 0);
            const int t = 16 * tb + fr3, i0_ = 16 * ib + 4 * fq3;
#pragma unroll
            for (int e = 0; e < 4; ++e) { const bool lt = (i0_ + e) < t, le = (i0_ + e) <= t; dab[e] = lt ? dab[e] : 0.f; dak[e] = lt ? dak[e] : 0.f; dbr[e] = le ? dbr[e] : 0.f; dkr[e] = le ? dkr[e] : 0.f; }
#pragma unroll
            for (int e = 0; e < 4; ++e) *(LAS float*)(lds + O_NABI + (i0_ + e) * FP + t * 4) = dab[e];
            *(LAS f32x4*)(lds + O_NAK + t * FP + i0_ * 4) = dak;
            { v2u w; w.x = pk2(dbr[0], dbr[1]); w.y = pk2(dbr[2], dbr[3]); *(LAS v2u*)(lds + O_NBRT + t * RS + i0_ * 2) = w; }
            nkr[u] = dkr; } }
        __syncthreads();
        if (!(PK & 2)) {
        if (wave < 4) { const int tb = wave, r = lane & 15;
            float x[16];
#pragma unroll
            for (int cI = 0; cI < 16; ++cI) x[cI] = (cI == r) ? 1.0f : 0.0f;
            const LAS unsigned char* nb_ = lds + O_NABI + (16 * tb) * FP + (16 * tb) * 4;
#pragma unroll
            for (int i = 0; i < 15; ++i) { const float xi = x[i];
#pragma unroll
                for (int g = (i + 1) / 4; g < 4; ++g) { const f32x4 n4 = *(const LAS f32x4*)(nb_ + i * FP + g * 16);
#pragma unroll
                    for (int e = 0; e < 4; ++e) if (4 * g + e > i) x[4 * g + e] += xi * n4[e]; } }
            if (lane < 16) {
#pragma unroll
                for (int g = 0; g < 4; ++g) *(LAS f32x4*)(lds + O_TBB + tb * 1280 + r * 80 + g * 16) = (f32x4){x[4 * g], x[4 * g + 1], x[4 * g + 2], x[4 * g + 3]}; } }
        __syncthreads();
        { f32x4 XT[4];
#pragma unroll
          for (int tb = 0; tb < 4; ++tb) { f32x4 R;
            if (wave < 4) {
#pragma unroll
                for (int e = 0; e < 4; ++e) R[e] = bf2f(*(const LAS bf16*)(lds + O_AT + (16 * tb + 4 * fq + e) * RS + (16 * wave + fr) * 2)); }
            else {
#pragma unroll
                for (int e = 0; e < 4; ++e) R[e] = *(const LAS float*)(lds + O_NAK + (16 * tb + 4 * fq + e) * FP + (16 * (wave - 4) + fr) * 4); }
#pragma unroll
            for (int tbp = 0; tbp < tb; ++tbp)
#pragma unroll
                for (int rho = 0; rho < 4; ++rho) { const float a_ = *(const LAS float*)(lds + O_NABI + (16 * tbp + 4 * fq + rho) * FP + (16 * tb + fr) * 4);
                    R = __builtin_amdgcn_mfma_f32_16x16x4f32(a_, XT[tbp][rho], R, 0, 0, 0); }
            f32x4 Xn = {0.f, 0.f, 0.f, 0.f};
#pragma unroll
            for (int rho = 0; rho < 4; ++rho) { const float a_ = *(const LAS float*)(lds + O_TBB + tb * 1280 + (4 * fq + rho) * 80 + fr * 4);
                Xn = __builtin_amdgcn_mfma_f32_16x16x4f32(a_, R[rho], Xn, 0, 0, 0); }
            XT[tb] = Xn;
            LAS unsigned char* dst = lds + (wave < 4 ? O_AHT : O_WM) + (16 * (wave & 3) + fr) * RS + (16 * tb + 4 * fq) * 2;
            { v2u w; w.x = pk2(Xn[0], Xn[1]); w.y = pk2(Xn[2], Xn[3]); *(LAS v2u*)dst = w; } } }
        }
        __syncthreads();
        { const int rb = wave >> 1, cb0 = 2 * (wave & 1);
          asm volatile("" : "+v"(fr3), "+v"(fq3));
          const bf16x8 ah0 = FRG(O_AHT, rb, 0), ah1 = FRG(O_AHT, rb, 1), wm0 = FRG(O_WM, rb, 0), wm1 = FRG(O_WM, rb, 1);
#pragma unroll
          for (int u = 0; u < 2; ++u) { const int cb = cb0 + u;
            const bf16x8 nb0 = FRG(O_NBRT, cb, 0), nb1 = FRG(O_NBRT, cb, 1), bh0 = FRG(O_BHT, cb, 0), bh1 = FRG(O_BHT, cb, 1);
            const int n_ = 16 * cb + fr3, m4 = 16 * rb + 4 * fq3;
            { const v2u rw = *(const LAS v2u*)(lds + O_RT + n_ * RS + m4 * 2); f32x4 d = {bflo(rw.x), bfhi(rw.x), bflo(rw.y), bfhi(rw.y)};
              d = __builtin_amdgcn_mfma_f32_16x16x32_bf16(ah0, nb0, d, 0, 0, 0); d = __builtin_amdgcn_mfma_f32_16x16x32_bf16(ah1, nb1, d, 0, 0, 0);
              v2u w; w.x = pk2(d[0], d[1]); w.y = pk2(d[2], d[3]);
              if (PK == 0 || P.ws == nullptr) *(v2u*)(QH + it4 + (size_t)n_ * 64 + 32 * (rb >> 1) + 8 * fq3 + 4 * (rb & 1)) = w; }
            { f32x4 d = nkr[u];
              d = __builtin_amdgcn_mfma_f32_16x16x32_bf16(wm0, nb0, d, 0, 0, 0); d = __builtin_amdgcn_mfma_f32_16x16x32_bf16(wm1, nb1, d, 0, 0, 0);
              v2u w; w.x = pk2(d[0], d[1]); w.y = pk2(d[2], d[3]); if (PK == 0 || P.ws == nullptr) *(v2u*)(GT + it4 + (size_t)n_ * 64 + m4) = w; }
            { f32x4 d = {0.f, 0.f, 0.f, 0.f};
              d = __builtin_amdgcn_mfma_f32_16x16x32_bf16(ah0, bh0, d, 0, 0, 0); d = __builtin_amdgcn_mfma_f32_16x16x32_bf16(ah1, bh1, d, 0, 0, 0);
              f32x4 hi, lo;
#pragma unroll
              for (int e = 0; e < 4; ++e) { float v = d[e]; if (m4 + e == n_) v += GC[n_]; const float vh = __uint_as_float(f2bf(v) << 16); hi[e] = vh; lo[e] = v - vh; }
              bf16* pmh = (bf16*)PM + 2 * it4; bf16* pml = pmh + 4096;
              const size_t o_ = (size_t)n_ * 64 + 32 * (rb >> 1) + 8 * fq3 + 4 * (rb & 1);
              { v2u w; w.x = pk2(hi[0], hi[1]); w.y = pk2(hi[2], hi[3]); if (PK == 0 || P.ws == nullptr) *(v2u*)(pmh + o_) = w; }
              { v2u w; w.x = pk2(lo[0], lo[1]); w.y = pk2(lo[2], lo[3]); if (PK == 0 || P.ws == nullptr) *(v2u*)(pml + o_) = w; } }
            { f32x4 d;
#pragma unroll
              for (int e = 0; e < 4; ++e) d[e] = bf2f(*(const LAS bf16*)(lds + O_KH + (m4 + e) * RS + n_ * 2));
              d = __builtin_amdgcn_mfma_f32_16x16x32_bf16(wm0, bh0, d, 0, 0, 0); d = __builtin_amdgcn_mfma_f32_16x16x32_bf16(wm1, bh1, d, 0, 0, 0);
              v2u w; w.x = pk2(d[0], d[1]); w.y = pk2(d[2], d[3]); if (PK == 0 || P.ws == nullptr) *(v2u*)(LT + it4 + (size_t)n_ * 64 + m4) = w; } } }
#undef FRG
        __syncthreads();
    }
}


__device__ __forceinline__ float wave_sum_fast(float x) {
    x = allreduce16(x);
    const float s0 = __int_as_float(__builtin_amdgcn_readlane(__float_as_int(x), 0)), s1 = __int_as_float(__builtin_amdgcn_readlane(__float_as_int(x), 16)),
                s2 = __int_as_float(__builtin_amdgcn_readlane(__float_as_int(x), 32)), s3 = __int_as_float(__builtin_amdgcn_readlane(__float_as_int(x), 48));
    return (s0 + s1) + (s2 + s3);
}
__device__ __forceinline__ void rwb_compute(LAS unsigned char* bb, LAS float* yb, pg8::f32x4 (&ST)[4], int nt, int fr, int fq) {
    using pg8::bf16x8; using pg8::f32x4;
    constexpr int RS = 144, T64 = 64 * RS, O_QH = 0, O_GT = T64, O_LT = 2 * T64, O_VT = 3 * T64, O_PH = 4 * T64, O_PL = 5 * T64, YP = 65;
#define FRG(base, rblk, ks) (*(const LAS bf16x8*)((base) + ((rblk) * 16 + fr) * RS + ((ks) * 32 + fq * 8) * 2))
    bf16x8 sh[2], sl[2];
#pragma unroll
    for (int s = 0; s < 2; ++s) { v4u wh, wl; unsigned* ph = (unsigned*)&wh; unsigned* pl = (unsigned*)&wl;
#pragma unroll
        for (int q = 0; q < 4; ++q) { const f32x4 v = ST[2 * s + (q >> 1)]; const float a = v[2 * (q & 1)], c = v[2 * (q & 1) + 1];
            const unsigned ha = f2bf(a), hc = f2bf(c); ph[q] = ha | (hc << 16);
            pl[q] = pk2(a - __uint_as_float(ha << 16), c - __uint_as_float(hc << 16)); }
        sh[s] = __builtin_bit_cast(bf16x8, wh); sl[s] = __builtin_bit_cast(bf16x8, wl); }
    const bf16x8 vt0 = FRG(bb + O_VT, nt, 0), vt1 = FRG(bb + O_VT, nt, 1);
#pragma unroll
    for (int tt = 0; tt < 4; ++tt) { f32x4 d = {0.f, 0.f, 0.f, 0.f};
        d = __builtin_amdgcn_mfma_f32_16x16x32_bf16(FRG(bb + O_QH, tt, 0), sh[0], d, 0, 0, 0);
        d = __builtin_amdgcn_mfma_f32_16x16x32_bf16(FRG(bb + O_QH, tt, 1), sh[1], d, 0, 0, 0);
        d = __builtin_amdgcn_mfma_f32_16x16x32_bf16(FRG(bb + O_GT, tt, 0), vt0, d, 0, 0, 0);
        d = __builtin_amdgcn_mfma_f32_16x16x32_bf16(FRG(bb + O_GT, tt, 1), vt1, d, 0, 0, 0);
#pragma unroll
        for (int e = 0; e < 4; ++e) yb[(16 * tt + 4 * fq + e) * YP + 16 * nt + fr] = d[e]; }
    f32x4 SN[4];
#pragma unroll
    for (int mt = 0; mt < 4; ++mt) { f32x4 d = {0.f, 0.f, 0.f, 0.f};
#pragma unroll
        for (int s = 0; s < 2; ++s) { const bf16x8 ph_ = FRG(bb + O_PH, mt, s), pl_ = FRG(bb + O_PL, mt, s);
            d = __builtin_amdgcn_mfma_f32_16x16x32_bf16(pl_, sh[s], d, 0, 0, 0);
            d = __builtin_amdgcn_mfma_f32_16x16x32_bf16(ph_, sl[s], d, 0, 0, 0);
            d = __builtin_amdgcn_mfma_f32_16x16x32_bf16(ph_, sh[s], d, 0, 0, 0); }
        d = __builtin_amdgcn_mfma_f32_16x16x32_bf16(FRG(bb + O_LT, mt, 0), vt0, d, 0, 0, 0);
        d = __builtin_amdgcn_mfma_f32_16x16x32_bf16(FRG(bb + O_LT, mt, 1), vt1, d, 0, 0, 0);
        SN[mt] = d; }
#pragma unroll
    for (int mt = 0; mt < 4; ++mt) ST[mt] = SN[mt];
#undef FRG
}
template <int PK> __device__ __forceinline__ void rwb(const Ptrs& P, LAS unsigned char* lds, int tid, int lane, int wave, int bh) {
    using pg8::bf16x8; using pg8::f32x4; using pg8::bflo; using pg8::bfhi;
    constexpr int RS = 144, T64 = 64 * RS, YP = 65;
    constexpr int O_QH = 0, O_GT = T64, O_LT = 2 * T64, O_VT = 3 * T64, O_PH = 4 * T64, O_PL = 5 * T64, BUFSZ = 6 * T64;
    constexpr int O_Y = 2 * BUFSZ;
    static_assert(O_Y + 2 * 64 * YP * 4 <= LDS_MISC, "rwb LDS map");
    unsigned char* ws = P.ws;
    const bf16 *GG = (const bf16*)(ws + WS_GG2), *QH = (const bf16*)(ws + WS_QH), *GT = (const bf16*)(ws + WS_GT), *LT = (const bf16*)(ws + WS_LT), *VTT = (const bf16*)(ws + WS_VTT);
    const bf16* PMB = (const bf16*)((unsigned char*)P.out + DO_PM); const float* BON = (const float*)(ws + WS_BON);
    bf16* OCAT = (bf16*)(ws + WS_OCAT);
    const int b = bh >> 3, h = bh & 7, fr = lane & 15, fq = lane >> 4;
    v4u gA_t[6], gB_t[6]; unsigned short pg_gg[16]; float pg_bon[16]; v4u pg_v[2];
#define RB_LOAD(S, cidx) do { const size_t it_ = (size_t)(bh * 32 + (cidx)) * 4096; const size_t o_ = it_ + (tid >> 3) * 64 + (tid & 7) * 8; \
        g##S##_t[0] = *(const v4u*)(QH + o_); g##S##_t[1] = *(const v4u*)(GT + o_); g##S##_t[2] = *(const v4u*)(LT + o_); g##S##_t[3] = *(const v4u*)(VTT + o_); \
        g##S##_t[4] = *(const v4u*)(PMB + it_ + o_); g##S##_t[5] = *(const v4u*)(PMB + it_ + 4096 + o_); } while (0)
#define RB_WRITE(S, bufoff) do { LAS unsigned char* d_ = lds + (bufoff) + (tid >> 3) * RS + (tid & 7) * 16; \
        *(LAS v4u*)(d_ + O_QH) = g##S##_t[0]; *(LAS v4u*)(d_ + O_GT) = g##S##_t[1]; *(LAS v4u*)(d_ + O_LT) = g##S##_t[2]; *(LAS v4u*)(d_ + O_VT) = g##S##_t[3]; \
        *(LAS v4u*)(d_ + O_PH) = g##S##_t[4]; *(LAS v4u*)(d_ + O_PL) = g##S##_t[5]; } while (0)
    f32x4 ST[4];
#pragma unroll
    for (int j = 0; j < 4; ++j) ST[j] = (f32x4){0.f, 0.f, 0.f, 0.f};
    const int pch = h * 64 + lane;
    float gnw = 0.f, gnb = 0.f;
    if (wave >= 4) { gnw = P.in[I_GNW][pch]; gnb = P.in[I_GNB][pch]; }
    RB_LOAD(A, 0); RB_WRITE(A, 0); RB_LOAD(B, 1);
    __syncthreads();
#define RB_ITER(c, LS, WS) do { \
        const int cur = ((c) & 1) * BUFSZ, nxt = (((c) & 1) ^ 1) * BUFSZ; \
        if (!(PK & 4)) { if ((c) + 1 < 32) RB_WRITE(WS, nxt); if ((c) + 2 < 32) RB_LOAD(LS, (c) + 2); } \
        if (wave < 4) { if ((c) < 32 && !(PK & 2)) rwb_compute(lds + cur, (LAS float*)(lds + O_Y + ((c) & 1) * 64 * YP * 4), ST, wave, fr, fq); } \
        else { \
            if ((c) >= 1 && !(PK & 1)) { LAS float* yb = (LAS float*)(lds + O_Y + (((c) - 1) & 1) * 64 * YP * 4); const int w4 = wave - 4; \
                float s_ = 0.f, q_ = 0.f; { const LAS float* yr = yb + (w4 * 16 + fr) * YP + 16 * fq; \
                    _Pragma("unroll") for (int i_ = 0; i_ < 16; ++i_) { const float y_ = yr[i_]; s_ += y_; q_ += y_ * y_; } } \
                s_ += __shfl_xor(s_, 16); s_ += __shfl_xor(s_, 32); q_ += __shfl_xor(q_, 16); q_ += __shfl_xor(q_, 32); \
                const float mean_l = s_ * (1.0f / 64.0f); const float rstd_l = 1.0f / sqrtf(fmaxf(q_ * (1.0f / 64.0f) - mean_l * mean_l, 0.f) + 64e-5f);     \
                _Pragma("unroll") for (int k_ = 0; k_ < 16; ++k_) { const int t = w4 * 16 + k_; \
                    const float mean = __int_as_float(__builtin_amdgcn_readlane(__float_as_int(mean_l), k_)), rstd = __int_as_float(__builtin_amdgcn_readlane(__float_as_int(rstd_l), k_)); \
                    const unsigned vw_ = pg_v[k_ >> 3][(k_ >> 1) & 3]; const float v = (k_ & 1) ? bfhi(vw_) : bflo(vw_); const float y = yb[t * YP + lane]; \
                    float yn = (y - mean) * rstd * gnw + gnb; yn += pg_bon[k_] * v; \
                    *(LAS bf16*)((LAS unsigned char*)yb + t * (YP * 4) + lane * 2) = (bf16)f2bf(yn * bf2f(pg_gg[k_])); } \
                LDS_WAIT(); asm volatile("" ::: "memory"); \
                  \
                _Pragma("unroll") for (int q2 = 0; q2 < 2; ++q2) { const int id_ = lane + 64 * q2, r_ = id_ >> 3, p_ = id_ & 7; const int t = w4 * 16 + r_; \
                    const unsigned* op_ = (const unsigned*)0; (void)op_; const LAS unsigned* ow_ = (const LAS unsigned*)((const LAS unsigned char*)yb + t * (YP * 4) + p_ * 16); const v4u o_ = {ow_[0], ow_[1], ow_[2], ow_[3]}; \
                    if (PK == 0 || P.ws == nullptr) *(v4u*)(OCAT + ((size_t)b * SEQ + (size_t)((c) - 1) * 64 + t) * 1024 + 512 + h * 64 + p_ * 8) = o_; } } \
            if ((c) < 32) { const size_t itv_ = (size_t)(bh * 32 + (c)) * 4096 + (size_t)lane * 64 + (wave - 4) * 16; pg_v[0] = *(const v4u*)(VTT + itv_); pg_v[1] = *(const v4u*)(VTT + itv_ + 8); \
                _Pragma("unroll") for (int k_ = 0; k_ < 16; ++k_) { const size_t m = (size_t)b * SEQ + (size_t)(c) * 64 + (wave - 4) * 16 + k_; pg_gg[k_] = GG[m * 512 + pch]; pg_bon[k_] = BON[m * 8 + h]; } } } \
        LDS_WAIT(); __syncthreads(); } while (0)
#pragma unroll 1
    for (int c = 0; c <= 32; c += 2) { RB_ITER(c, A, B); if (c + 1 <= 32) RB_ITER(c + 1, B, A); }
#undef RB_ITER
#undef RB_LOAD
#undef RB_WRITE
}

#define XB_TMO      128
#define XB_XCNT(j)  (256  + 64 * (j))
#define XB_XSUB(j)  (1280 + 64 * (j))
#define XB_XGEN(j)  (2304 + 64 * (j))
#define XB_TOP      3328
#define XB_TOPGEN   3392
#define XCD_BAR_WORDS 3456
#define XB_SPIN_CAP (1u << 18)

__device__ __forceinline__ unsigned xb_ld(unsigned* p)              { return __hip_atomic_load(p, __ATOMIC_RELAXED, __HIP_MEMORY_SCOPE_AGENT); }
__device__ __forceinline__ unsigned xb_add(unsigned* p, unsigned v) { return __hip_atomic_fetch_add(p, v, __ATOMIC_RELAXED, __HIP_MEMORY_SCOPE_AGENT); }
__device__ __forceinline__ unsigned xb_xcc_id() { return (unsigned)__builtin_amdgcn_s_getreg((3 << 11) | 20) & 0xFu; }
#define XB_SPIN(cond, bar) do { unsigned _sp = 0; while (cond) { __builtin_amdgcn_s_sleep(1); \
    if ((++_sp & 255u) == 0u) { if (xb_ld(&(bar)[XB_TMO])) break; if (_sp > XB_SPIN_CAP) { atomicAdd(&(bar)[XB_TMO], 1u); break; } } } } while (0)

struct XcdBarrier {
    unsigned* bar; unsigned x;
    volatile LAS unsigned* st;
};

__device__ __forceinline__ XcdBarrier xcd_barrier_post(unsigned* bar, volatile LAS unsigned* st) {
    XcdBarrier b; b.bar = bar; b.x = xb_xcc_id(); b.st = st;
    if (threadIdx.x == 0) (void)xb_add(&bar[XB_XCNT(b.x)], 1u);
    return b;
}
__device__ __forceinline__ void xcd_barrier_complete(unsigned* bar, unsigned x, unsigned& nloc, unsigned& nx) {
    const unsigned G = gridDim.x * gridDim.y * gridDim.z;
    unsigned sum, cnt, mine, sp = 0u;
    for (;;) {
        sum = 0u; cnt = 0u; mine = 0u;
#pragma unroll
        for (unsigned j = 0; j < 16; ++j) { const unsigned c = xb_ld(&bar[XB_XCNT(j)]); sum += c; cnt += (c > 0u) ? 1u : 0u; mine = (j == x) ? c : mine; }
        if (sum == G) break;
        __builtin_amdgcn_s_sleep(1);
        if ((++sp & 255u) == 0u) { if (xb_ld(&bar[XB_TMO])) break; if (sp > XB_SPIN_CAP) { atomicAdd(&bar[XB_TMO], 1u); break; } }
    }
    nloc = mine > 0u ? mine : 1u; nx = cnt > 0u ? cnt : 1u;
}

__device__ __forceinline__ void xcd_barrier(const XcdBarrier& b) {
    asm volatile("s_waitcnt vmcnt(0)" ::: "memory");
    __syncthreads();
    if (threadIdx.x == 0) {
        unsigned* bar = b.bar;
        __builtin_amdgcn_s_waitcnt(0);
        unsigned nloc = b.st[0], nx = b.st[1];
        if (nloc == 0u) { xcd_barrier_complete(bar, b.x, nloc, nx); b.st[0] = nloc; b.st[1] = nx; }
        const unsigned old = xb_add(&bar[XB_XSUB(b.x)], 1u);
        const unsigned gen = old / nloc;
        if (old + 1u == (gen + 1u) * nloc) {
            __builtin_amdgcn_fence(__ATOMIC_RELEASE, "agent");
            asm volatile("s_waitcnt vmcnt(0)" ::: "memory");
            const unsigned og = xb_add(&bar[XB_TOP], 1u);
            const unsigned tg = og / nx;
            if (og + 1u == (tg + 1u) * nx) xb_add(&bar[XB_TOPGEN], 1u);
            else XB_SPIN(xb_ld(&bar[XB_TOPGEN]) == tg, bar);
            __builtin_amdgcn_fence(__ATOMIC_ACQUIRE, "agent");
            xb_add(&bar[XB_XGEN(b.x)], 1u);
            asm volatile("s_waitcnt vmcnt(0)" ::: "memory");
        } else {
            XB_SPIN(xb_ld(&bar[XB_XGEN(b.x)]) == gen, bar);
            __builtin_amdgcn_fence(__ATOMIC_ACQUIRE, "agent");
            asm volatile("s_waitcnt vmcnt(0)" ::: "memory");
        }
    }
    __syncthreads();
}

struct Args { const float* in[27]; float* out; unsigned char* ws; int ph_lo, ph_hi; };
constexpr int NPHASE = 9;
__global__ void __launch_bounds__(512, 2) mega(Args args) {
    extern __shared__ __attribute__((aligned(16))) unsigned char lds_raw[];
    LAS unsigned char* lds = (LAS unsigned char*)lds_raw;
    const int tid = threadIdx.x, lane = tid & 63, wave = __builtin_amdgcn_readfirstlane(tid >> 6);
    Ptrs P;
#pragma unroll
    for (int i = 0; i < 27; ++i) P.in[i] = args.in[i];
    P.out = args.out; P.ws = args.ws;
    unsigned char* ws = args.ws;
    const int lo = args.ph_lo, hi = args.ph_hi, G = gridDim.x, bx = blockIdx.x;
#define IN(k) (lo <= (k) && (k) < hi)
#define SEAM(k) do { if (IN(k) && IN((k) + 1)) xcd_barrier(bar); } while (0)
    float* SS2 = (float*)(ws + WS_SS); float* SS3 = SS2 + M; float* SS4 = SS3 + M;
    XcdBarrier bar; bar.bar = (unsigned*)(ws + WS_BAR); bar.x = 0; bar.st = (volatile LAS unsigned*)(lds + LDS_MISC);
    if (hi - lo > 1) { if (tid < 2) ((volatile LAS unsigned*)(lds + LDS_MISC))[tid] = 0u; __syncthreads(); bar = xcd_barrier_post((unsigned*)(ws + WS_BAR), (volatile LAS unsigned*)(lds + LDS_MISC)); }
    bf16* ABUF = (bf16*)(ws + WS_ABUF);

    if (IN(0)) { p0_prologue(P, lds, tid, lane, wave); } SEAM(0);
    if (IN(1)) {
      {
        pg8::Gemm g{ABUF, (const bf16*)(ws + WS_WIN), M, NZ, D}; pg8::StaticOrder S; S.init(M, NZ, G, bx);
        pg8::EpiStoreBf16 E{(bf16*)(ws + WS_Z), NZ};
        pg8::gemm_phase<pg8::EpiStoreBf16, pg8::StaticOrder, true, true>(lds, g, S, E); }
    } SEAM(1);
    if (IN(2)) {
        gla_pre2(P, lds, tid, lane, wave);
#if (PROBE_DUP & 16384)
        __syncthreads(); for (int i_ = tid; i_ < 131072 / 16; i_ += 512) *(LAS v4u*)(lds + i_ * 16) = (v4u){0xFFFFFFFFu, 0xFFFFFFFFu, 0xFFFFFFFFu, 0xFFFFFFFFu}; __syncthreads();
#endif
#if (PROBE_DUP & 1024)
        rwa<PROBE_RWA>(P, lds, tid, lane, wave);
#endif
        rwa<0>(P, lds, tid, lane, wave);
#if (PROBE_DUP & 1)
        rwa<PROBE_RWA>(P, lds, tid, lane, wave);
#endif
#if (PROBE_DUP & 2048)
        __syncthreads(); for (int i_ = tid; i_ < 131072 / 16; i_ += 512) *(LAS v4u*)(lds + i_ * 16) = (v4u){0xFFFFFFFFu, 0xFFFFFFFFu, 0xFFFFFFFFu, 0xFFFFFFFFu}; __syncthreads();
#endif
#if (PROBE_DUP & 512)
        if (bx & 1) { for (int i_ = 0; i_ < 100; ++i_) __builtin_amdgcn_s_sleep(127); }
#endif
#if (PROBE_DUP & 1)
        rwkv_pre2(P, lds, tid, lane, wave);
#endif
#if (PROBE_DUP & 2)
        gla_pre2(P, lds, tid, lane, wave);
#endif
    } SEAM(2);
    if (IN(3)) {
        if (bx < 128) rwb<0>(P, lds, tid, lane, wave, bx); else if (bx < 192) gla_scan(P, lds, tid, lane, wave, bx - 128);
        else p0_late_weights(P, lds, tid, lane, wave, bx - 192, G - 192);
#if (PROBE_DUP & 4)
        __syncthreads();
        if (bx < 128) rwb<PROBE_RWB>(P, lds, tid, lane, wave, bx);
#endif
#if (PROBE_DUP & 8)
        __syncthreads();
        if (bx >= 128 && bx < 192) gla_scan(P, lds, tid, lane, wave, bx - 128);
#endif
    } SEAM(3);
    if (IN(4)) {
        { pg8::Gemm g{(const bf16*)(ws + WS_OCAT), (const bf16*)(ws + WS_WOUT), M, D, D}; pg8::StaticOrder S; S.init(M, D, G, bx);
          pg8::EpiRes<false> E{P.in[I_X], nullptr, nullptr, ABUF, P.in[I_LNMLP], SS2};
          pg8::gemm_phase<pg8::EpiRes<false>, pg8::StaticOrder, true, true>(lds, g, S, E); }
        { pg8::Gemm g{(const bf16*)(ws + WS_PB), (const bf16*)(ws + WS_WP), M, D, PLE}; pg8::StaticOrder S; S.init(M, D, G, bx);
          pg8::EpiStoreBf16 E{(bf16*)(ws + WS_PP), D};
          pg8::gemm_phase<pg8::EpiStoreBf16, pg8::StaticOrder, true, true>(lds, g, S, E);
#if (PROBE_DUP & 4096)
          pg8::gemm_phase<pg8::EpiStoreBf16, pg8::StaticOrder, true, true>(lds, g, S, E);
#endif
        }
#if (PROBE_DUP & 8192)
        { pg8::Gemm g{(const bf16*)(ws + WS_OCAT), (const bf16*)(ws + WS_WOUT), M, D, D}; pg8::StaticOrder S; S.init(M, D, G, bx);
          pg8::EpiStoreBf16 E{(bf16*)(ws + WS_PP), D};
          pg8::gemm_phase<pg8::EpiStoreBf16, pg8::StaticOrder, true, true>(lds, g, S, E); }
        { pg8::Gemm g{(const bf16*)(ws + WS_PB), (const bf16*)(ws + WS_WP), M, D, PLE}; pg8::StaticOrder S; S.init(M, D, G, bx);
          pg8::EpiStoreBf16 E{(bf16*)(ws + WS_PP), D};
          pg8::gemm_phase<pg8::EpiStoreBf16, pg8::StaticOrder, true, true>(lds, g, S, E); }
#endif
    } SEAM(4);
    if (IN(5)) {
      {
        pg8::Gemm g{ABUF, (const bf16*)(ws + WS_W1), M, FF, D}; pg8::StaticOrder S; S.init(M, FF, G, bx);
        pg8::EpiFF1 E{(bf16*)(ws + WS_HFF), FF, SS2, EPS};
        pg8::gemm_phase<pg8::EpiFF1, pg8::StaticOrder, true, true>(lds, g, S, E);
#if (PROBE_DUP & 128)
        pg8::gemm_phase<pg8::EpiFF1, pg8::StaticOrder, true, true>(lds, g, S, E);
#endif
        }
    } SEAM(5);
    if (IN(6)) {
        pg8::Gemm g{(const bf16*)(ws + WS_HFF), (const bf16*)(ws + WS_W2), M, D, FF}; pg8::StaticOrder S; S.init(M, D, G, bx);
        pg8::EpiRes<true> E{nullptr, ABUF, P.in[I_LNMLP], ABUF, P.in[I_LNPLE], SS3};
        pg8::gemm_phase<pg8::EpiRes<true>, pg8::StaticOrder, true, true>(lds, g, S, E);
    } SEAM(6);
    if (IN(7)) {
        pg8::Gemm g{ABUF, (const bf16*)(ws + WS_WG), M, D, D}; pg8::StaticOrder S; S.init(M, D, G, bx);
        pg8::EpiGate E{ABUF, P.in[I_LNPLE], (const bf16*)(ws + WS_PP), P.out, SS3, SS4, EPS};
        pg8::gemm_phase<pg8::EpiGate, pg8::StaticOrder, true, true>(lds, g, S, E);
    } SEAM(7);
    if (IN(8)) {
        const float* gf = P.in[I_LNFIN]; pg8::f32x4 gv[4];
#pragma unroll
        for (int j = 0; j < 4; ++j) gv[j] = *((const pg8::f32x4*)gf + lane + 64 * j);
        pg8::f32x4 v[4], vn[4]; float ssn = 0.f, ssc = 0.f;
        { const int m = bx * 8 + wave; if (m < M) { ssc = SS4[m]; const pg8::f32x4* orow = (const pg8::f32x4*)(P.out + (size_t)m * D) + lane;
#pragma unroll
            for (int j = 0; j < 4; ++j) v[j] = orow[64 * j]; } }
        for (int m = bx * 8 + wave; m < M; m += G * 8) {
            const int mn = m + G * 8;
            if (mn < M) { ssn = SS4[mn]; const pg8::f32x4* orow = (const pg8::f32x4*)(P.out + (size_t)mn * D) + lane;
#pragma unroll
                for (int j = 0; j < 4; ++j) vn[j] = orow[64 * j]; }
            const float rs = 1.0f / sqrtf(ssc * (1.0f / D) + EPS);
            pg8::f32x4* orow = (pg8::f32x4*)(P.out + (size_t)m * D) + lane;
#pragma unroll
            for (int j = 0; j < 4; ++j) orow[64 * j] = v[j] * rs * gv[j];
#pragma unroll
            for (int j = 0; j < 4; ++j) v[j] = vn[j];
            ssc = ssn;
        }
    }
#undef IN
#undef SEAM
}

#ifndef MK_ONE_LAUNCH
#define MK_ONE_LAUNCH 1
#endif
extern "C" void kernel_launch(void* const* d_in, const int* in_sizes, int n_in, void* d_out, int out_size, void* d_ws, size_t ws_size, hipStream_t stream) {
    static int grid = 0;
    if (grid == 0) {
        if (n_in != 27 || in_sizes[0] != M * D || out_size != M * D || ws_size < WS_END) { fprintf(stderr, "kernel_launch: unexpected shapes (n_in %d in0 %d out %d ws %zu)\n", n_in, n_in > 0 ? in_sizes[0] : -1, out_size, ws_size); grid = -1; return; }
        int dev = 0, cus = 0, per_cu = 0;
        (void)hipGetDevice(&dev); (void)hipDeviceGetAttribute(&cus, hipDeviceAttributeMultiprocessorCount, dev);
        if (hipFuncSetAttribute((const void*)mega, hipFuncAttributeMaxDynamicSharedMemorySize, LDS_BYTES) != hipSuccess) { fprintf(stderr, "kernel_launch: hipFuncSetAttribute failed\n"); grid = -1; return; }
        (void)hipOccupancyMaxActiveBlocksPerMultiprocessor(&per_cu, (const void*)mega, 512, LDS_BYTES);
        if (per_cu < 1) { fprintf(stderr, "kernel_launch: occupancy query says %d blocks per CU\n", per_cu); }
        (void)hipGetLastError();
        grid = cus;
    }
    if (grid < 0) return;
    Args a{};
    for (int i = 0; i < 27; ++i) a.in[i] = (const float*)d_in[i];
    a.out = (float*)d_out; a.ws = (unsigned char*)d_ws;
#if MK_ONE_LAUNCH
    a.ph_lo = 0; a.ph_hi = NPHASE;
    if (hipMemsetAsync((unsigned char*)d_ws + WS_BAR, 0, XCD_BAR_WORDS * 4, stream) != hipSuccess) { fprintf(stderr, "kernel_launch: memset of the barrier words failed\n"); return; }
    hipLaunchKernelGGL(mega, dim3(grid), dim3(512), LDS_BYTES, stream, a);
#else
    for (int ph = 0; ph < NPHASE; ++ph) { a.ph_lo = ph; a.ph_hi = ph + 1; hipLaunchKernelGGL(mega, dim3(grid), dim3(512), LDS_BYTES, stream, a); }
#endif
}
```

```cpp
#include <hip/hip_runtime.h>
#include <hip/hip_cooperative_groups.h>
#include <cstdio>
#include <cstdint>
namespace cg = cooperative_groups;

#define GAS __attribute__((address_space(1)))
#define LAS __attribute__((address_space(3)))
typedef unsigned short bf16;
typedef unsigned v4u __attribute__((ext_vector_type(4)));
typedef unsigned v2u __attribute__((ext_vector_type(2)));

namespace pg8 {
#define PG8_LAS __attribute__((address_space(3)))
typedef unsigned short bf16_t;
typedef short bf16x8 __attribute__((ext_vector_type(8)));
typedef float f32x4 __attribute__((ext_vector_type(4)));
typedef unsigned u32x4 __attribute__((ext_vector_type(4)));
typedef unsigned u32x2 __attribute__((ext_vector_type(2)));
constexpr int BM = 256, BK = 64, HALF = 128, HTB = HALF * BK * 2  , STAGE_BYTES = 8 * HTB, NXCD = 8, WGM = 8;

__host__ __device__ __forceinline__ int lds_byte(int r, int c) { const int st = (r >> 4) * 2 + (c >> 5), rr = r & 15, cc = c & 31, ob = rr * 64 + cc * 2; return st * 1024 + (ob ^ (((ob >> 9) & 1) << 5)); }
__host__ __device__ __forceinline__ void stage_rc(int b, int& R, int& C) { const int st = b / 1024, sb = b % 1024, swz = sb ^ (((sb >> 9) & 1) << 5); R = (st >> 1) * 16 + swz / 64; C = (st & 1) * 32 + (swz % 64) / 2; }
__host__ __device__ __forceinline__ int perm32(int rho) { const int n = rho >> 4, i = rho & 15; return 8 * (i >> 2) + 4 * n + (i & 3); }

struct Unit { int pm, pn; };
struct Gemm { const bf16_t* A; const bf16_t* Bt; int M, N, K; };

struct StaticOrder {
    int nM, nN, nwg, G, c;
    __host__ __device__ void init(int M, int N, int G_, int c_) { nM = M / BM; nN = N / BM; nwg = nM * nN; G = G_; c = c_; }
    __host__ __device__ bool next(int i, Unit& u) const {
        const long L = (long)i * G + c; if (L >= nwg) return false;
        int wgid = (int)L; { const int q = nwg / NXCD, r = nwg % NXCD, xcd = wgid % NXCD, off = wgid / NXCD; wgid = (xcd < r ? xcd * (q + 1) : r * (q + 1) + (xcd - r) * q) + off; }
        const int nig = WGM * nN, gid = wgid / nig, fm = gid * WGM, gsz = (nM - fm) < WGM ? (nM - fm) : WGM;
        u.pm = fm + ((wgid % nig) % gsz); u.pn = (wgid % nig) / gsz; return true;
    }
    __device__ __forceinline__ void a_ready(const Unit&) const {}
    __device__ __forceinline__ void done(const Unit&) const {}
};

typedef float f32x2c __attribute__((ext_vector_type(2)));
typedef __bf16 bf16x2c __attribute__((ext_vector_type(2)));
__device__ __forceinline__ unsigned cvt_pk_bf16(float lo, float hi) { const f32x2c v = {lo, hi}; return __builtin_bit_cast(unsigned, __builtin_convertvector(v, bf16x2c)); }
__device__ __forceinline__ float frcp(float x) { return __builtin_amdgcn_rcpf(x); }
__device__ __forceinline__ float frsq(float x) { return __builtin_amdgcn_rsqf(x); }
__device__ __forceinline__ float bflo(unsigned w) { return __uint_as_float(w << 16); }
__device__ __forceinline__ float bfhi(unsigned w) { return __uint_as_float(w & 0xffff0000u); }
__device__ __forceinline__ void atomic_addf(float* p, float v) { __hip_atomic_fetch_add(p, v, __ATOMIC_RELAXED, __HIP_MEMORY_SCOPE_AGENT); }

struct EpiStoreBf16 {
    static constexpr bool PERM = true, AFTER_DRAIN = false;
    bf16_t* O; int ldc;
    __device__ __forceinline__ void operator()(const f32x4 (&acc)[2][2][4][2], const Unit& u, int wr, int wc, int fr, int fq) const {
        const int row0 = u.pm * BM + wr * 64 + fr, col0 = u.pn * BM + wc * 32 + 8 * fq;
#pragma unroll
        for (int ai = 0; ai < 2; ++ai)
#pragma unroll
            for (int m = 0; m < 4; ++m) { bf16_t* rowp = O + (size_t)(row0 + ai * HALF + m * 16) * ldc + col0;
#pragma unroll
                for (int bj = 0; bj < 2; ++bj) { const f32x4 v0 = acc[ai][bj][m][0], v1 = acc[ai][bj][m][1];
                    u32x4 w; w.x = cvt_pk_bf16(v0[0], v0[1]); w.y = cvt_pk_bf16(v0[2], v0[3]); w.z = cvt_pk_bf16(v1[0], v1[1]); w.w = cvt_pk_bf16(v1[2], v1[3]);
                    *(u32x4*)(rowp + bj * HALF) = w; } }
    }
};
struct EpiFF1 {
    static constexpr bool PERM = true, AFTER_DRAIN = false;
    bf16_t* O; int ldc; const float* ss; float eps;
    __device__ __forceinline__ void operator()(const f32x4 (&acc)[2][2][4][2], const Unit& u, int wr, int wc, int fr, int fq) const {
        const int row0 = u.pm * BM + wr * 64 + fr, col0 = u.pn * BM + wc * 32 + 8 * fq;
#pragma unroll
        for (int ai = 0; ai < 2; ++ai)
#pragma unroll
            for (int m = 0; m < 4; ++m) { const int row = row0 + ai * HALF + m * 16; bf16_t* rowp = O + (size_t)row * ldc + col0;
                const float rs = frsq(ss[row] * (1.0f / 1024.0f) + eps);
#pragma unroll
                for (int bj = 0; bj < 2; ++bj) { f32x4 v0 = acc[ai][bj][m][0] * rs, v1 = acc[ai][bj][m][1] * rs;
#pragma unroll
                    for (int j = 0; j < 4; ++j) { const float a = fmaxf(v0[j], 0.f), b = fmaxf(v1[j], 0.f); v0[j] = a * a; v1[j] = b * b; }
                    u32x4 w; w.x = cvt_pk_bf16(v0[0], v0[1]); w.y = cvt_pk_bf16(v0[2], v0[3]); w.z = cvt_pk_bf16(v1[0], v1[1]); w.w = cvt_pk_bf16(v1[2], v1[3]);
                    *(u32x4*)(rowp + bj * HALF) = w; } }
    }
};
template <bool BASE_BF16> struct EpiRes {
    static constexpr bool PERM = false, AFTER_DRAIN = false;
    const float* basef; const bf16_t* baseb; const float* gprev; bf16_t* A; const float* gain; float* ss;
    __device__ __forceinline__ void operator()(const f32x4 (&acc)[2][2][4][2], const Unit& u, int wr, int wc, int fr, int fq) const {
        const int row0 = u.pm * BM + wr * 64 + fr, col0 = u.pn * BM + wc * 32 + 4 * fq;
        f32x4 gv[2][2], gi[2][2];
#pragma unroll
        for (int bj = 0; bj < 2; ++bj)
#pragma unroll
            for (int n = 0; n < 2; ++n) { gv[bj][n] = *(const f32x4*)(gain + col0 + bj * HALF + n * 16);
                if (BASE_BF16) { const f32x4 gp = *(const f32x4*)(gprev + col0 + bj * HALF + n * 16); gi[bj][n] = (f32x4){frcp(gp[0]), frcp(gp[1]), frcp(gp[2]), frcp(gp[3])}; } }
#pragma unroll
        for (int ai = 0; ai < 2; ++ai)
#pragma unroll
            for (int m = 0; m < 4; ++m) { const int row = row0 + ai * HALF + m * 16; const size_t off = (size_t)row * 1024 + col0; float q = 0.f;
#pragma unroll
                for (int bj = 0; bj < 2; ++bj)
#pragma unroll
                    for (int n = 0; n < 2; ++n) { const size_t o = off + bj * HALF + n * 16; f32x4 bs;
                        if (BASE_BF16) { const u32x2 bw = *(const u32x2*)(baseb + o); bs = (f32x4){bflo(bw.x), bfhi(bw.x), bflo(bw.y), bfhi(bw.y)} * gi[bj][n]; }
                        else bs = *(const f32x4*)(basef + o);
                        const f32x4 h = bs + acc[ai][bj][m][n];
                        q += (h[0] * h[0] + h[1] * h[1]) + (h[2] * h[2] + h[3] * h[3]);
                        const f32x4 a = h * gv[bj][n]; u32x2 w; w.x = cvt_pk_bf16(a[0], a[1]); w.y = cvt_pk_bf16(a[2], a[3]); *(u32x2*)(A + o) = w; }
                q += __shfl_xor(q, 16); q += __shfl_xor(q, 32);
                if (fq == 0) atomic_addf(ss + row, q);
                asm volatile("" ::: "memory"); }
    }
};
struct EpiGate {
    static constexpr bool PERM = false, AFTER_DRAIN = false;
    const bf16_t* hb; const float* gprev; const bf16_t* pp; float* out; const float* ss_in; float* ss_out; float eps;
    __device__ __forceinline__ void operator()(const f32x4 (&acc)[2][2][4][2], const Unit& u, int wr, int wc, int fr, int fq) const {
        const int row0 = u.pm * BM + wr * 64 + fr, col0 = u.pn * BM + wc * 32 + 4 * fq;
        f32x4 gi[2][2];
#pragma unroll
        for (int bj = 0; bj < 2; ++bj)
#pragma unroll
            for (int n = 0; n < 2; ++n) { const f32x4 gp = *(const f32x4*)(gprev + col0 + bj * HALF + n * 16); gi[bj][n] = (f32x4){frcp(gp[0]), frcp(gp[1]), frcp(gp[2]), frcp(gp[3])}; }
#pragma unroll
        for (int ai = 0; ai < 2; ++ai)
#pragma unroll
            for (int m = 0; m < 4; ++m) { const int row = row0 + ai * HALF + m * 16; const size_t off = (size_t)row * 1024 + col0; float q = 0.f;
                const float rs = frsq(ss_in[row] * (1.0f / 1024.0f) + eps);
#pragma unroll
                for (int bj = 0; bj < 2; ++bj)
#pragma unroll
                    for (int n = 0; n < 2; ++n) { const size_t o = off + bj * HALF + n * 16; const u32x2 hw = *(const u32x2*)(hb + o); const f32x4 hv = (f32x4){bflo(hw.x), bfhi(hw.x), bflo(hw.y), bfhi(hw.y)} * gi[bj][n]; const u32x2 pw = *(const u32x2*)(pp + o);
                        const f32x4 g = acc[ai][bj][m][n] * rs; f32x4 r;
                        r[0] = hv[0] + bflo(pw.x) * frcp(1.0f + __expf(-g[0])); r[1] = hv[1] + bfhi(pw.x) * frcp(1.0f + __expf(-g[1]));
                        r[2] = hv[2] + bflo(pw.y) * frcp(1.0f + __expf(-g[2])); r[3] = hv[3] + bfhi(pw.y) * frcp(1.0f + __expf(-g[3]));
                        *(f32x4*)(out + o) = r; q += (r[0] * r[0] + r[1] * r[1]) + (r[2] * r[2] + r[3] * r[3]); }
                q += __shfl_xor(q, 16); q += __shfl_xor(q, 32);
                if (fq == 0) atomic_addf(ss_out + row, q);
                asm volatile("" ::: "memory"); }
    }
};

template <class Epi, class Sched, bool ALIGN_EPI = false, bool SP2 = false>
__device__ __forceinline__ void gemm_phase(PG8_LAS unsigned char* lds, const Gemm g, const Sched& S, const Epi& E) {
    const int tid = threadIdx.x, wid = __builtin_amdgcn_readfirstlane(tid >> 6), lane = tid & 63, wr = wid >> 2, wc = wid & 3, fr = lane & 15, fq = lane >> 4;
    const int K = g.K, nt = K / BK;
    unsigned voffA[2], voffB[2];
#pragma unroll
    for (int i = 0; i < 2; ++i) { int R, C; stage_rc(tid * 16 + i * 8192, R, C); const int Rb = Epi::PERM ? ((R & ~31) + perm32(R & 31)) : R;
        voffA[i] = (unsigned)(R * K + C) * 2u; voffB[i] = (unsigned)(Rb * K + C) * 2u; }
    const size_t kstep = (size_t)(BK * 2);
    const size_t hstep = (size_t)HALF * K * 2;
    const size_t tstep = 2 * hstep;
    const unsigned ldsw = (unsigned)wid * 1024u;
    const int aoff = lds_byte(wr * 64 + fr, fq * 8), boff = lds_byte(wc * 32 + fr, fq * 8);
#define PG8_SA(b, h) (((b) * 2 + (h)) * HTB)
#define PG8_SB(b, h) ((4 + (b) * 2 + (h)) * HTB)
#define PG8_STAGE(bufoff, gbase, voff) do { _Pragma("unroll") for (int _i = 0; _i < 2; ++_i) \
        __builtin_amdgcn_global_load_lds((const unsigned*)((const char*)(gbase) + (voff)[_i]), (PG8_LAS unsigned*)(lds + (bufoff) + ldsw + _i * 8192), 16, 0, 0); } while (0)
#define PG8_LDA(dst, b, h) do { _Pragma("unroll") for (int m = 0; m < 4; ++m) _Pragma("unroll") for (int k = 0; k < 2; ++k) dst[m][k] = *(const PG8_LAS bf16x8*)(lds + PG8_SA(b, h) + aoff + m * 2048 + k * 1024); } while (0)
#define PG8_LDB(dst, b, h) do { _Pragma("unroll") for (int n = 0; n < 2; ++n) _Pragma("unroll") for (int k = 0; k < 2; ++k) dst[n][k] = *(const PG8_LAS bf16x8*)(lds + PG8_SB(b, h) + boff + n * 2048 + k * 1024); } while (0)
#define PG8_MMA(ai, bj, At, Bt) do { __builtin_amdgcn_s_setprio(1); _Pragma("unroll") for (int m = 0; m < 4; ++m) _Pragma("unroll") for (int n = 0; n < 2; ++n) _Pragma("unroll") for (int k = 0; k < 2; ++k) \
        acc[ai][bj][m][n] = __builtin_amdgcn_mfma_f32_16x16x32_bf16(Bt[n][k], At[m][k], acc[ai][bj][m][n], 0, 0, 0); __builtin_amdgcn_s_setprio(0); } while (0)
#define PG8_WAIT_V(n) asm volatile("s_waitcnt vmcnt(" #n ")" ::: "memory")
#define PG8_WAIT_L(n) asm volatile("s_waitcnt lgkmcnt(" #n ")" ::: "memory")
#define PG8_BAR __builtin_amdgcn_s_barrier()
#define PG8_SCHED __builtin_amdgcn_sched_barrier(0)
    Unit cur, nxt; int ui = 0;
    if (!S.next(0, cur)) return;
    f32x4 acc[2][2][4][2];
#pragma unroll
    for (int a = 0; a < 2; ++a)
#pragma unroll
        for (int b = 0; b < 2; ++b)
#pragma unroll
            for (int m = 0; m < 4; ++m)
#pragma unroll
                for (int n = 0; n < 2; ++n) acc[a][b][m][n] = (f32x4){0.f, 0.f, 0.f, 0.f};
    bf16x8 At[4][2], B0[2][2], B1[2][2];
    const char* cA = (const char*)g.A + (size_t)cur.pm * tstep; const char* cB = (const char*)g.Bt + (size_t)cur.pn * tstep;
    S.a_ready(cur);
    if constexpr (SP2) {
        PG8_STAGE(PG8_SB(0, 0), cB, voffB); PG8_STAGE(PG8_SB(0, 1), cB + hstep, voffB); PG8_STAGE(PG8_SA(0, 0), cA, voffA); PG8_STAGE(PG8_SA(0, 1), cA + hstep, voffA);
        if (wr == 1) PG8_BAR;
        PG8_WAIT_V(2); PG8_BAR;
        PG8_STAGE(PG8_SB(1, 0), cB + kstep, voffB); PG8_STAGE(PG8_SA(1, 0), cA + kstep, voffA); PG8_STAGE(PG8_SB(1, 1), cB + hstep + kstep, voffB);
        PG8_WAIT_V(6); PG8_BAR;
    } else {
        PG8_STAGE(PG8_SB(0, 0), cB, voffB); PG8_STAGE(PG8_SA(0, 0), cA, voffA); PG8_STAGE(PG8_SB(0, 1), cB + hstep, voffB); PG8_STAGE(PG8_SA(0, 1), cA + hstep, voffA);
        if (wr == 1) PG8_BAR;
        PG8_WAIT_V(4); PG8_BAR;
        PG8_STAGE(PG8_SB(1, 0), cB + kstep, voffB); PG8_STAGE(PG8_SA(1, 0), cA + kstep, voffA); PG8_STAGE(PG8_SB(1, 1), cB + hstep + kstep, voffB);
        PG8_WAIT_V(6); PG8_BAR;
    }
    for (;;) {
        const bool has_next = S.next(ui + 1, nxt);
        const char* nA = has_next ? (const char*)g.A + (size_t)nxt.pm * tstep : cA; const char* nB = has_next ? (const char*)g.Bt + (size_t)nxt.pn * tstep : cB;
        for (int t = 0; t < nt; t += 2) {
            const bool last = (t == nt - 2);
            const char* a1 = cA + (size_t)(t + 1) * kstep;
            const char* a2 = last ? nA : cA + (size_t)(t + 2) * kstep; const char* b2 = last ? nB : cB + (size_t)(t + 2) * kstep;
            const char* a3 = a2 + kstep; const char* b3 = b2 + kstep;
            if (last && has_next) S.a_ready(nxt);
            if constexpr (SP2) {
            PG8_LDB(B0, 0, 0); PG8_LDB(B1, 0, 1); PG8_SCHED; PG8_LDA(At, 0, 0); PG8_STAGE(PG8_SA(1, 1), a1 + hstep, voffA);
            PG8_WAIT_V(8); PG8_WAIT_L(0); PG8_BAR; PG8_MMA(0, 0, At, B0); PG8_MMA(0, 1, At, B1); PG8_BAR; PG8_SCHED;
            PG8_LDA(At, 0, 1); PG8_STAGE(PG8_SB(0, 0), b2, voffB); PG8_STAGE(PG8_SB(0, 1), b2 + hstep, voffB); PG8_STAGE(PG8_SA(0, 0), a2, voffA);
            PG8_WAIT_V(8); PG8_WAIT_L(0); PG8_BAR; PG8_MMA(1, 0, At, B0); PG8_MMA(1, 1, At, B1); PG8_BAR; PG8_SCHED;
            PG8_LDB(B0, 1, 0); PG8_LDB(B1, 1, 1); PG8_SCHED; PG8_LDA(At, 1, 0); PG8_STAGE(PG8_SA(0, 1), a2 + hstep, voffA);
            PG8_WAIT_V(8); PG8_WAIT_L(0); PG8_BAR; PG8_MMA(0, 0, At, B0); PG8_MMA(0, 1, At, B1); PG8_BAR; PG8_SCHED;
            PG8_LDA(At, 1, 1); PG8_STAGE(PG8_SB(1, 0), b3, voffB); PG8_STAGE(PG8_SB(1, 1), b3 + hstep, voffB); PG8_STAGE(PG8_SA(1, 0), a3, voffA);
            PG8_WAIT_V(8); PG8_WAIT_L(0); PG8_BAR; PG8_MMA(1, 0, At, B0); PG8_MMA(1, 1, At, B1); PG8_BAR; PG8_SCHED;
            } else {
            PG8_LDB(B0, 0, 0); PG8_SCHED; PG8_LDA(At, 0, 0); PG8_STAGE(PG8_SA(1, 1), a1 + hstep, voffA);
            PG8_WAIT_L(8); PG8_BAR; PG8_WAIT_L(0); PG8_MMA(0, 0, At, B0); PG8_BAR; PG8_SCHED;
            PG8_LDB(B1, 0, 1); PG8_STAGE(PG8_SB(0, 0), b2, voffB);
            PG8_BAR; PG8_WAIT_L(0); PG8_MMA(0, 1, At, B1); PG8_BAR;
            PG8_LDA(At, 0, 1); PG8_STAGE(PG8_SA(0, 0), a2, voffA);
            PG8_BAR; PG8_WAIT_L(0); PG8_MMA(1, 0, At, B0); PG8_BAR; PG8_SCHED;
            PG8_STAGE(PG8_SB(0, 1), b2 + hstep, voffB);
            PG8_WAIT_V(6); PG8_BAR; PG8_MMA(1, 1, At, B1); PG8_BAR;
            PG8_LDB(B0, 1, 0); PG8_SCHED; PG8_LDA(At, 1, 0); PG8_STAGE(PG8_SA(0, 1), a2 + hstep, voffA);
            PG8_WAIT_L(8); PG8_BAR; PG8_WAIT_L(0); PG8_MMA(0, 0, At, B0); PG8_BAR; PG8_SCHED;
            PG8_LDB(B1, 1, 1); PG8_STAGE(PG8_SB(1, 0), b3, voffB);
            PG8_BAR; PG8_WAIT_L(0); PG8_MMA(0, 1, At, B1); PG8_BAR;
            PG8_LDA(At, 1, 1); PG8_STAGE(PG8_SA(1, 0), a3, voffA);
            PG8_BAR; PG8_WAIT_L(0); PG8_MMA(1, 0, At, B0); PG8_BAR; PG8_SCHED;
            PG8_STAGE(PG8_SB(1, 1), b3 + hstep, voffB);
            PG8_WAIT_V(6); PG8_BAR; PG8_MMA(1, 1, At, B1); PG8_BAR;
            }
        }
        if constexpr (ALIGN_EPI) { if (wr == 0) PG8_BAR; }
        if constexpr (!Epi::AFTER_DRAIN) { E(acc, cur, wr, wc, fr, fq); S.done(cur); }
        if (!has_next) break;
#pragma unroll
        for (int a = 0; a < 2; ++a)
#pragma unroll
            for (int b = 0; b < 2; ++b)
#pragma unroll
                for (int m = 0; m < 4; ++m)
#pragma unroll
                    for (int n = 0; n < 2; ++n) acc[a][b][m][n] = (f32x4){0.f, 0.f, 0.f, 0.f};
        cur = nxt; cA = nA; cB = nB; ++ui;
        if constexpr (ALIGN_EPI) { if (wr == 1) PG8_BAR; }
    }
    PG8_WAIT_V(0);
    if constexpr (!ALIGN_EPI) { if (wr == 0) PG8_BAR; }
    PG8_BAR;
    if constexpr (Epi::AFTER_DRAIN) { E.fused(acc, cur, wr, wc, fr, fq, lds, wid, lane); S.done(cur); }
#undef PG8_SA
#undef PG8_SB
#undef PG8_STAGE
#undef PG8_LDA
#undef PG8_LDB
#undef PG8_MMA
#undef PG8_WAIT_V
#undef PG8_WAIT_L
#undef PG8_BAR
#undef PG8_SCHED
}
}
#ifndef PROBE_DUP
#define PROBE_DUP 0
#endif
#ifndef PROBE_RWB
#define PROBE_RWB 0
#endif
#ifndef PROBE_RWA
#define PROBE_RWA 0
#endif

constexpr int NB = 16, SEQ = 2048, D = 1024, M = NB * SEQ, FF = 4096, PLE = 256, DIN = 3248, NZ = 3328;
constexpr float EPS = 1e-6f;
constexpr int ZQ = 0, ZK = 256, ZV = 512, ZG = 1024, ZRR = 1536, ZRK = 2048, ZRV = 2560, ZGK = 3072, ZLOW = 3088  ;
__host__ __device__ __forceinline__ int zmap(int n) { return n < 1536 ? n : (n < 1552 ? n + 1536 : (n < 3088 ? n - 16 : n)); }

constexpr size_t MiB = 1u << 20;
constexpr size_t WS_LWT = 512 * 1024;
constexpr size_t WS_BAR = 768 * 1024;
constexpr size_t WS_SS = 0;
constexpr size_t WS_WIN = 1 * MiB, WS_WOUT = 8 * MiB, WS_W1 = 10 * MiB, WS_W2 = 18 * MiB, WS_WG = 26 * MiB, WS_WP = 28 * MiB;
constexpr size_t WS_PB = 29 * MiB;
constexpr size_t WS_ABUF = 45 * MiB;
constexpr size_t WS_Z = 109 * MiB;
constexpr size_t WS_OCAT = 317 * MiB;
constexpr size_t WS_KF = 381 * MiB, WS_KK = 413 * MiB, WS_BB = 445 * MiB, WS_GG = 477 * MiB;
constexpr size_t WS_BON = 509 * MiB;
constexpr size_t WS_EL = 510 * MiB;
constexpr size_t WS_END = 512 * MiB;
constexpr size_t WS_VT = WS_ABUF, WS_HFF = WS_Z, WS_PP = WS_KF, WS_H3 = WS_Z;
constexpr size_t DO_DEC = 0, DO_QT = 64 * MiB, DO_KT = 80 * MiB, DO_KDT = 96 * MiB;

constexpr int LDS_BYTES = 147456, LDS_MISC = 147000;

__device__ __forceinline__ float bf2f(bf16 b) { return __uint_as_float(((unsigned)b) << 16); }
typedef float f32x2_t __attribute__((ext_vector_type(2)));
typedef __bf16 bf16x2_t __attribute__((ext_vector_type(2)));
__device__ __forceinline__ unsigned pk2(float lo, float hi) { const f32x2_t v = {lo, hi}; return __builtin_bit_cast(unsigned, __builtin_convertvector(v, bf16x2_t)); }
__device__ __forceinline__ unsigned f2bf(float f) { return pk2(f, f) & 0xffffu; }
#define LDS_WAIT() asm volatile("s_waitcnt lgkmcnt(0)" ::: "memory")
__device__ __forceinline__ float wave_sum(float v) {
#pragma unroll
    for (int o = 1; o < 64; o <<= 1) v += __shfl_xor(v, o);
    return v;
}
__device__ __forceinline__ float sigmoidf(float x) { return 1.0f / (1.0f + expf(-x)); }
__device__ __forceinline__ float frcp(float x) { return __builtin_amdgcn_rcpf(x); }
__device__ __forceinline__ float frsq(float x) { return __builtin_amdgcn_rsqf(x); }

struct Ptrs {
    const float* in[27]; float* out; unsigned char* ws;
};
enum { I_X = 0, I_P, I_LNMIX, I_WIN, I_CONVW, I_GKW, I_GKB, I_NORMG, I_MU, I_W0, I_W2, I_A0, I_A2, I_G2, I_KK, I_KA, I_RK, I_GNW, I_GNB, I_WOUT, I_LNMLP, I_WFF1, I_WFF2, I_LNPLE, I_WGATE, I_WPP, I_LNFIN };

template <bool ZMAP>
__device__ __forceinline__ void p0_transpose_item(const float* W, int K, int N, bf16* WT, LAS float* scr, int item, int lane) {
    const int nblk = (N + 31) / 32, kb = item / nblk, nb = item % nblk, k0 = 64 * kb, n0 = 32 * nb;
    { const int n = n0 + (lane & 31);
#pragma unroll 8
      for (int i = 0; i < 32; ++i) { const int kk = 2 * i + (lane >> 5); scr[kk * 33 + (lane & 31)] = (n < N) ? W[(size_t)(k0 + kk) * N + n] : 0.f; } }
    LDS_WAIT(); asm volatile("" ::: "memory");
    const int c = lane & 7;
#pragma unroll
    for (int j = 0; j < 4; ++j) { const int nl = (lane >> 3) + 8 * j, n = n0 + nl; const LAS float* s = scr + (8 * c) * 33 + nl;
        v4u o; o.x = pk2(s[0 * 33], s[1 * 33]); o.y = pk2(s[2 * 33], s[3 * 33]); o.z = pk2(s[4 * 33], s[5 * 33]); o.w = pk2(s[6 * 33], s[7 * 33]);
        if (n < N) { const int dst = ZMAP ? zmap(n) : n; *(v4u*)(WT + (size_t)dst * K + k0 + 8 * c) = o; } }
    LDS_WAIT(); asm volatile("" ::: "memory");
}
__device__ __forceinline__ void p0_late_weights(const Ptrs& P, LAS unsigned char* lds, int tid, int lane, int wave, int wk, int nwk) {
    unsigned char* ws = P.ws;
    LAS float* scr = (LAS float*)(lds + wave * 16384);
    const int gw = wk * 8 + wave, NGW = nwk * 8;
    const size_t gt = (size_t)wk * 512 + tid, NGT = (size_t)nwk * 512;
    constexpr int I_O = 16 * 32, I_1 = 16 * 128, I_2 = 64 * 32, I_G = 16 * 32, I_PP = 4 * 32;
    constexpr int NITEMS = I_O + I_1 + I_2 + I_G + I_PP;
    for (int it = gw; it < NITEMS; it += NGW) {
        int r = it;
        if (r < I_PP) { p0_transpose_item<false>(P.in[I_WPP], PLE, D, (bf16*)(ws + WS_WP), scr, r, lane); continue; } r -= I_PP;
        if (r < I_O) { p0_transpose_item<false>(P.in[I_WOUT], D, D, (bf16*)(ws + WS_WOUT), scr, r, lane); continue; } r -= I_O;
        if (r < I_1) { p0_transpose_item<false>(P.in[I_WFF1], D, FF, (bf16*)(ws + WS_W1), scr, r, lane); continue; } r -= I_1;
        if (r < I_2) { p0_transpose_item<false>(P.in[I_WFF2], FF, D, (bf16*)(ws + WS_W2), scr, r, lane); continue; } r -= I_2;
        p0_transpose_item<false>(P.in[I_WGATE], D, D, (bf16*)(ws + WS_WG), scr, r, lane);
    }
    { const pg8::f32x4* pp = (const pg8::f32x4*)P.in[I_P]; v2u* pb = (v2u*)(ws + WS_PB);
      for (size_t i = gt; i < (size_t)M * PLE / 4; i += NGT) { const pg8::f32x4 v = pp[i]; v2u w; w.x = pk2(v[0], v[1]); w.y = pk2(v[2], v[3]); pb[i] = w; } }
}
__device__ __forceinline__ void p0_prologue(const Ptrs& P, LAS unsigned char* lds, int tid, int lane, int wave) {
    unsigned char* ws = P.ws;
    LAS float* scr = (LAS float*)(lds + wave * 16384);
    const int gw = blockIdx.x * 8 + wave, NGW = gridDim.x * 8;
    const size_t gt = (size_t)blockIdx.x * 512 + tid, NGT = (size_t)gridDim.x * 512;
    constexpr int I_IN = 16 * 102;
    for (int it = gw; it < I_IN; it += NGW) p0_transpose_item<true>(P.in[I_WIN], D, DIN, (bf16*)(ws + WS_WIN), scr, it, lane);
    { v4u* wp = (v4u*)((bf16*)(ws + WS_WIN) + (size_t)DIN * D); for (size_t i = gt; i < 10240; i += NGT) wp[i] = (v4u){0u, 0u, 0u, 0u};
      v4u* sp = (v4u*)(ws + WS_SS); for (size_t i = gt; i < 24576; i += NGT) sp[i] = (v4u){0u, 0u, 0u, 0u}; }
    { bf16* LWT = (bf16*)(ws + WS_LWT);
      for (size_t i = gt; i < 512 * 160; i += NGT) { const int c = (int)(i / 160), k = (int)(i % 160);
          const float v = k < 32 ? P.in[I_W2][k * 512 + c] : (k < 64 ? P.in[I_A2][(k - 32) * 512 + c] : P.in[I_G2][(k - 64) * 512 + c]);
          LWT[i] = (bf16)f2bf(v); } }
    { const float* g = P.in[I_LNMIX]; pg8::f32x4 gv[4];
#pragma unroll
      for (int j = 0; j < 4; ++j) gv[j] = *((const pg8::f32x4*)g + lane + 64 * j);
      bf16* XN = (bf16*)(ws + WS_ABUF);
      pg8::f32x4 v[4], vn[4];
      if (gw < M) { const pg8::f32x4* xr = (const pg8::f32x4*)(P.in[I_X] + (size_t)gw * D) + lane;
#pragma unroll
          for (int j = 0; j < 4; ++j) v[j] = xr[64 * j]; }
      for (int m = gw; m < M; m += NGW) {
        if (m + NGW < M) { const pg8::f32x4* xr = (const pg8::f32x4*)(P.in[I_X] + (size_t)(m + NGW) * D) + lane;
#pragma unroll
            for (int j = 0; j < 4; ++j) vn[j] = xr[64 * j]; }
        float s = 0.f;
#pragma unroll
        for (int j = 0; j < 4; ++j) s += (v[j][0] * v[j][0] + v[j][1] * v[j][1]) + (v[j][2] * v[j][2] + v[j][3] * v[j][3]);
        const float rstd = frsq(wave_sum(s) * (1.0f / D) + EPS);
        v2u* o8 = (v2u*)(XN + (size_t)m * D) + lane;
#pragma unroll
        for (int j = 0; j < 4; ++j) { v2u w; w.x = pk2(v[j][0] * rstd * gv[j][0], v[j][1] * rstd * gv[j][1]); w.y = pk2(v[j][2] * rstd * gv[j][2], v[j][3] * rstd * gv[j][3]); o8[64 * j] = w; }
#pragma unroll
        for (int j = 0; j < 4; ++j) v[j] = vn[j];
      } }
}

__device__ __forceinline__ void rwkv_pre(const Ptrs& P, LAS unsigned char* lds, int tid, int lane, int wave) {
    unsigned char* ws = P.ws;
    const bf16* Z = (const bf16*)(ws + WS_Z);
    float* DEC = (float*)((unsigned char*)P.out + DO_DEC);
    bf16 *KF = (bf16*)(ws + WS_KF), *KK = (bf16*)(ws + WS_KK), *BB = (bf16*)(ws + WS_BB), *GG = (bf16*)(ws + WS_GG);
    float* BON = (float*)(ws + WS_BON);
    const float* mu = P.in[I_MU];
    const int c = tid;
    float w2c[32], a2c[32], g2c[96];
#pragma unroll
    for (int i = 0; i < 32; ++i) { w2c[i] = P.in[I_W2][i * 512 + c]; a2c[i] = P.in[I_A2][i * 512 + c]; }
#pragma unroll
    for (int i = 0; i < 96; ++i) g2c[i] = P.in[I_G2][i * 512 + c];
    const float w0c = P.in[I_W0][c], a0c = P.in[I_A0][c], kkc = P.in[I_KK][c], kac = P.in[I_KA][c], rkc = P.in[I_RK][c];
    const float mur = mu[c], muk = mu[512 + c];
    LAS float* low = (LAS float*)lds;
    for (int item = blockIdx.x; item < M / 32; item += gridDim.x) {
        const int m0 = item * 32;
#pragma unroll 2
        for (int j = 0; j < 10; ++j) { const int idx = tid + 512 * j, tt = idx / 160, i = idx - tt * 160, m = m0 + tt;
            const float zc = bf2f(Z[(size_t)m * NZ + ZLOW + i]); const float zp = ((m & (SEQ - 1)) == 0) ? 0.f : bf2f(Z[(size_t)(m - 1) * NZ + ZLOW + i]);
            float x = zc + mu[1536 + i] * (zp - zc);
            if (i < 32) x = tanhf(x); else if (i >= 64) x = sigmoidf(x);
            low[idx] = x; }
        __syncthreads();
        float zrp, zkp;
        if ((m0 & (SEQ - 1)) == 0) { zrp = 0.f; zkp = 0.f; }
        else { zrp = bf2f(Z[(size_t)(m0 - 1) * NZ + ZRR + c]); zkp = bf2f(Z[(size_t)(m0 - 1) * NZ + ZRK + c]); }
#pragma unroll 1
        for (int tt = 0; tt < 32; ++tt) { const int m = m0 + tt;
            const float zr = bf2f(Z[(size_t)m * NZ + ZRR + c]), zk = bf2f(Z[(size_t)m * NZ + ZRK + c]);
            const float r = zr + mur * (zrp - zr), k = zk + muk * (zkp - zk); zrp = zr; zkp = zk;
            const LAS float* lw = low + tt * 160;
            float wa = w0c, aa = a0c, ga = 0.f;
#pragma unroll
            for (int i = 0; i < 32; ++i) { wa += lw[i] * w2c[i]; aa += lw[32 + i] * a2c[i]; }
#pragma unroll
            for (int i = 0; i < 96; ++i) ga += lw[64 + i] * g2c[i];
            const float nw = -wa;
            const float sp = fmaxf(nw, 0.f) + log1pf(expf(-fabsf(nw)));
            const float dec = expf(-expf(-sp - 0.5f));
            const float a = sigmoidf(aa);
            float kk = k * kkc; const float ssq = wave_sum(kk * kk); kk = kk / fmaxf(sqrtf(ssq), 1e-12f);
            const float kf = k * (1.0f + (a - 1.0f) * kac);
            const float bon = wave_sum(r * kf * rkc);
            const size_t o = (size_t)m * 512 + c;
            DEC[o] = dec; KF[o] = (bf16)f2bf(kf); KK[o] = (bf16)f2bf(kk); BB[o] = (bf16)f2bf(kk * a); GG[o] = (bf16)f2bf(ga);
            if (lane == 0) BON[(size_t)m * 8 + wave] = bon; }
        __syncthreads();
    }
}
__device__ __forceinline__ void gla_pre(const Ptrs& P, LAS unsigned char* lds, int tid, int lane, int wave) {
    unsigned char* ws = P.ws;
    const bf16* Z = (const bf16*)(ws + WS_Z);
    bf16 *QT = (bf16*)((unsigned char*)P.out + DO_QT), *KT = (bf16*)((unsigned char*)P.out + DO_KT), *KDT = (bf16*)((unsigned char*)P.out + DO_KDT), *VT = (bf16*)(ws + WS_VT);
    float* EL = (float*)(ws + WS_EL);
    LAS float* bbuf = (LAS float*)lds;
    const float* cwp = P.in[I_CONVW];
    for (int item = blockIdx.x; item < NB * 32; item += gridDim.x) {
        const int b = item >> 5, c = item & 31, mbase = b * SEQ + c * 64;
        if (tid < 256) { const int d = tid; float gkw[16];
#pragma unroll
            for (int i = 0; i < 16; ++i) gkw[i] = P.in[I_GKW][i * 256 + d];
            const float gkb = P.in[I_GKB][d]; float bc = 0.f;
#pragma unroll 1
            for (int t = 0; t < 64; ++t) { const bf16* zr = Z + (size_t)(mbase + t) * NZ + ZGK; float pre = gkb;
#pragma unroll
                for (int i = 0; i < 16; ++i) pre += bf2f(zr[i]) * gkw[i];
                const float ls = fminf(pre, 0.f) - log1pf(expf(-fabsf(pre)));
                bc += ls * (1.0f / 16.0f); bbuf[t * 256 + d] = bc; }
            EL[(size_t)(((b * 4 + (d >> 6)) * 32 + c) * 64) + (d & 63)] = expf(bc); }
        __syncthreads();
#pragma unroll 1
        for (int rep = 0; rep < 2; ++rep) { const int ch = tid + 512 * rep;
            const float cw0 = cwp[ch], cw1 = cwp[1024 + ch], cw2 = cwp[2048 + ch], cw3 = cwp[3072 + ch];
            float x3 = 0.f, x2 = 0.f, x1 = 0.f;
            if (c > 0) { x3 = bf2f(Z[(size_t)(mbase - 3) * NZ + ch]); x2 = bf2f(Z[(size_t)(mbase - 2) * NZ + ch]); x1 = bf2f(Z[(size_t)(mbase - 1) * NZ + ch]); }
            const int d = ch & 255, hq = d >> 6, dk = d & 63;
            const size_t tile = (size_t)((b * 4 + hq) * 32 + c) * 4096;
            const float blast = bbuf[63 * 256 + d];
            const int e = ch - 512, hv = e >> 7, dv = e & 127;
            const size_t vtile = (size_t)((b * 4 + hv) * 32 + c) * 8192;
#pragma unroll 1
            for (int t = 0; t < 64; ++t) { const float x = bf2f(Z[(size_t)(mbase + t) * NZ + ch]);
                const float y = cw0 * x3 + cw1 * x2 + cw2 * x1 + cw3 * x; x3 = x2; x2 = x1; x1 = x;
                const float s = y / (1.0f + expf(-y));
                if (ch < 256) { const float bt = bbuf[t * 256 + d]; QT[tile + t * 64 + dk] = (bf16)f2bf(s * 0.125f * expf(bt)); }
                else if (ch < 512) { const float bt = bbuf[t * 256 + d]; KT[tile + t * 64 + dk] = (bf16)f2bf(s * expf(-bt)); KDT[tile + dk * 64 + t] = (bf16)f2bf(s * expf(blast - bt)); }
                else { VT[vtile + dv * 64 + t] = (bf16)f2bf(s); } } }
        __syncthreads();
    }
}

__device__ __forceinline__ float fast_tanh(float x) { return 1.0f - 2.0f * frcp(__expf(2.0f * x) + 1.0f); }
__device__ __forceinline__ float fast_sigmoid(float x) { return frcp(1.0f + __expf(-x)); }
__device__ __forceinline__ void rwkv_pre2(const Ptrs& P, LAS unsigned char* lds, int tid, int lane, int wave) {
    using pg8::bf16x8; using pg8::f32x4; using pg8::bflo; using pg8::bfhi;
    constexpr int TT = 64, LP = 336, OFF_C = TT * LP;
    unsigned char* ws = P.ws;
    const bf16* Z = (const bf16*)(ws + WS_Z);
    float* DEC = (float*)((unsigned char*)P.out + DO_DEC);
    bf16 *KF = (bf16*)(ws + WS_KF), *KK = (bf16*)(ws + WS_KK), *BB = (bf16*)(ws + WS_BB), *GG = (bf16*)(ws + WS_GG);
    float* BON = (float*)(ws + WS_BON);
    const float* mu = P.in[I_MU];
    const bf16* LWT = (const bf16*)(ws + WS_LWT);
    const int fr = lane & 15, fq = lane >> 4;
    LAS float* cst = (LAS float*)(lds + OFF_C);
    { const int i = tid; cst[i] = P.in[I_W0][i]; cst[512 + i] = P.in[I_A0][i]; cst[1024 + i] = P.in[I_KK][i]; cst[1536 + i] = P.in[I_KA][i]; cst[2048 + i] = P.in[I_RK][i]; cst[2560 + i] = mu[i]; cst[3072 + i] = mu[512 + i]; }
    __syncthreads();
    for (int item = blockIdx.x; item < M / TT; item += gridDim.x) {
        const int m0 = item * TT;
#pragma unroll 2
        for (int j = 0; j < 10; ++j) { const int pidx = tid + 512 * j, tt = pidx / 80, i = 2 * (pidx - tt * 80), m = m0 + tt;
            const unsigned zc = *(const unsigned*)(Z + (size_t)m * NZ + ZLOW + i); const unsigned zp = ((m & (SEQ - 1)) == 0) ? 0u : *(const unsigned*)(Z + (size_t)(m - 1) * NZ + ZLOW + i);
            float x0 = bflo(zc) + mu[1536 + i] * (bflo(zp) - bflo(zc)), x1 = bfhi(zc) + mu[1537 + i] * (bfhi(zp) - bfhi(zc));
            if (i < 32) { x0 = fast_tanh(x0); x1 = fast_tanh(x1); } else if (i >= 64) { x0 = fast_sigmoid(x0); x1 = fast_sigmoid(x1); }
            *(LAS unsigned*)(lds + tt * LP + i * 2) = pk2(x0, x1); }
        __syncthreads();
        bf16x8 wfa[4][2];
#pragma unroll
        for (int mt = 0; mt < 4; ++mt)
#pragma unroll
            for (int ks = 0; ks < 2; ++ks) wfa[mt][ks] = *(const bf16x8*)(LWT + (size_t)(64 * wave + 16 * mt + fr) * 160 + 32 * ks + 8 * fq);
#pragma unroll 1
        for (int tile = 0; tile < TT / 16; ++tile) {
            bf16x8 bl[2];
#pragma unroll
            for (int ks = 0; ks < 2; ++ks) bl[ks] = *(const LAS bf16x8*)(lds + (tile * 16 + fr) * LP + (32 * ks + 8 * fq) * 2);
            const int m = m0 + tile * 16 + fr; const bool first = (m & (SEQ - 1)) == 0;
            float ssq = 0.f, bon = 0.f; f32x4 kkv[4], av[4];
#pragma unroll
            for (int mt = 0; mt < 4; ++mt) { const int c0 = 64 * wave + 16 * mt + 4 * fq;
                const f32x4 z4 = {0.f, 0.f, 0.f, 0.f};
                const f32x4 Dw_ = __builtin_amdgcn_mfma_f32_16x16x32_bf16(wfa[mt][0], bl[0], z4, 0, 0, 0);
                const f32x4 Da_ = __builtin_amdgcn_mfma_f32_16x16x32_bf16(wfa[mt][1], bl[1], z4, 0, 0, 0);
                const v2u zr = *(const v2u*)(Z + (size_t)m * NZ + ZRR + c0), zk = *(const v2u*)(Z + (size_t)m * NZ + ZRK + c0);
                v2u zrp = {0u, 0u}, zkp = {0u, 0u};
                if (!first) { zrp = *(const v2u*)(Z + (size_t)(m - 1) * NZ + ZRR + c0); zkp = *(const v2u*)(Z + (size_t)(m - 1) * NZ + ZRK + c0); }
                const f32x4 w0 = *(const LAS f32x4*)(cst + c0), a0 = *(const LAS f32x4*)(cst + 512 + c0), kkc = *(const LAS f32x4*)(cst + 1024 + c0), kac = *(const LAS f32x4*)(cst + 1536 + c0),
                            rkc = *(const LAS f32x4*)(cst + 2048 + c0), mur = *(const LAS f32x4*)(cst + 2560 + c0), muk = *(const LAS f32x4*)(cst + 3072 + c0);
                const f32x4 zr4 = {bflo(zr.x), bfhi(zr.x), bflo(zr.y), bfhi(zr.y)}, zrp4 = {bflo(zrp.x), bfhi(zrp.x), bflo(zrp.y), bfhi(zrp.y)};
                const f32x4 zk4 = {bflo(zk.x), bfhi(zk.x), bflo(zk.y), bfhi(zk.y)}, zkp4 = {bflo(zkp.x), bfhi(zkp.x), bflo(zkp.y), bfhi(zkp.y)};
                const f32x4 r4 = zr4 + mur * (zrp4 - zr4), k4 = zk4 + muk * (zkp4 - zk4);
                f32x4 dec, kf, a4;
#pragma unroll
                for (int e = 0; e < 4; ++e) { const float nw = -(w0[e] + Dw_[e]);
                    const float sp = fmaxf(nw, 0.f) + __logf(1.0f + __expf(-fabsf(nw)));
                    dec[e] = __expf(-__expf(-sp - 0.5f));
                    a4[e] = fast_sigmoid(a0[e] + Da_[e]); }
                const f32x4 kk = k4 * kkc; kf = k4 * (1.0f + (a4 - 1.0f) * kac);
                ssq += (kk[0] * kk[0] + kk[1] * kk[1]) + (kk[2] * kk[2] + kk[3] * kk[3]);
                { const f32x4 t = r4 * kf * rkc; bon += (t[0] + t[1]) + (t[2] + t[3]); }
                kkv[mt] = kk; av[mt] = a4;
                const size_t o = (size_t)m * 512 + c0;
                *(f32x4*)(DEC + o) = dec;
                { v2u w; w.x = pk2(kf[0], kf[1]); w.y = pk2(kf[2], kf[3]); *(v2u*)(KF + o) = w; }
                asm volatile("" ::: "memory"); }
            ssq += __shfl_xor(ssq, 16); ssq += __shfl_xor(ssq, 32); bon += __shfl_xor(bon, 16); bon += __shfl_xor(bon, 32);
            const float inv = 1.0f / fmaxf(sqrtf(ssq), 1e-12f);
#pragma unroll
            for (int mt = 0; mt < 4; ++mt) { const int c0 = 64 * wave + 16 * mt + 4 * fq; const size_t o = (size_t)m * 512 + c0;
                const f32x4 kn = kkv[mt] * inv, bb = kn * av[mt];
                { v2u w; w.x = pk2(kn[0], kn[1]); w.y = pk2(kn[2], kn[3]); *(v2u*)(KK + o) = w; }
                { v2u w; w.x = pk2(bb[0], bb[1]); w.y = pk2(bb[2], bb[3]); *(v2u*)(BB + o) = w; } }
            if (fq == 0) BON[(size_t)m * 8 + wave] = bon;
        }
        {
            bf16x8 wfb[4][3];
#pragma unroll
            for (int mt = 0; mt < 4; ++mt)
#pragma unroll
                for (int ks = 0; ks < 3; ++ks) wfb[mt][ks] = *(const bf16x8*)(LWT + (size_t)(64 * wave + 16 * mt + fr) * 160 + 64 + 32 * ks + 8 * fq);
#pragma unroll 1
            for (int tile = 0; tile < TT / 16; ++tile) { const int m = m0 + tile * 16 + fr;
                bf16x8 bl[3];
#pragma unroll
                for (int ks = 0; ks < 3; ++ks) bl[ks] = *(const LAS bf16x8*)(lds + (tile * 16 + fr) * LP + (64 + 32 * ks + 8 * fq) * 2);
#pragma unroll
                for (int mt = 0; mt < 4; ++mt) { f32x4 g = {0.f, 0.f, 0.f, 0.f};
                    g = __builtin_amdgcn_mfma_f32_16x16x32_bf16(wfb[mt][0], bl[0], g, 0, 0, 0);
                    g = __builtin_amdgcn_mfma_f32_16x16x32_bf16(wfb[mt][1], bl[1], g, 0, 0, 0);
                    g = __builtin_amdgcn_mfma_f32_16x16x32_bf16(wfb[mt][2], bl[2], g, 0, 0, 0);
                    v2u w; w.x = pk2(g[0], g[1]); w.y = pk2(g[2], g[3]); *(v2u*)(GG + (size_t)m * 512 + 64 * wave + 16 * mt + 4 * fq) = w; } } }
        __syncthreads();
    }
}
__device__ __forceinline__ void gla_pre2(const Ptrs& P, LAS unsigned char* lds, int tid, int lane, int wave) {
    unsigned char* ws = P.ws;
    const bf16* __restrict__ Z = (const bf16*)(ws + WS_Z);
    bf16 *QT = (bf16*)((unsigned char*)P.out + DO_QT), *KT = (bf16*)((unsigned char*)P.out + DO_KT), *KDT = (bf16*)((unsigned char*)P.out + DO_KDT), *VT = (bf16*)(ws + WS_VT);
    float* EL = (float*)(ws + WS_EL);
    LAS float* bbuf = (LAS float*)lds;
    LAS float* gl = (LAS float*)(lds + 65536);
    const float* cwp = P.in[I_CONVW];
    for (int item = blockIdx.x; item < NB * 32; item += gridDim.x) {
        const int b = item >> 5, c = item & 31, mbase = b * SEQ + c * 64;
        { const int idx = tid * 2, t = idx >> 4, i = idx & 15; const unsigned z2 = *(const unsigned*)(Z + (size_t)(mbase + t) * NZ + ZGK + i); gl[idx] = pg8::bflo(z2); gl[idx + 1] = pg8::bfhi(z2); }
        __syncthreads();
        if (tid < 256) { const int d = tid; float gkw[16];
#pragma unroll
            for (int i = 0; i < 16; ++i) gkw[i] = P.in[I_GKW][i * 256 + d];
            const float gkb = P.in[I_GKB][d]; float bc = 0.f;
#pragma unroll 4
            for (int t = 0; t < 64; ++t) { float pre = gkb;
#pragma unroll
                for (int i = 0; i < 16; ++i) pre += gl[t * 16 + i] * gkw[i];
                const float ls = fminf(pre, 0.f) - __logf(1.0f + __expf(-fabsf(pre)));
                bc += ls * (1.0f / 16.0f); bbuf[t * 256 + d] = bc; }
            EL[(size_t)(((b * 4 + (d >> 6)) * 32 + c) * 64) + (d & 63)] = __expf(bc); }
        __syncthreads();
#pragma unroll 1
        for (int rep = 0; rep < 2; ++rep) { const int ch = tid + 512 * rep;
            const float cw0 = cwp[ch], cw1 = cwp[1024 + ch], cw2 = cwp[2048 + ch], cw3 = cwp[3072 + ch];
            float x3 = 0.f, x2 = 0.f, x1 = 0.f;
            if (c > 0) { x3 = bf2f(Z[(size_t)(mbase - 3) * NZ + ch]); x2 = bf2f(Z[(size_t)(mbase - 2) * NZ + ch]); x1 = bf2f(Z[(size_t)(mbase - 1) * NZ + ch]); }
            const int d = ch & 255, hq = d >> 6, dk = d & 63;
            const size_t tile = (size_t)((b * 4 + hq) * 32 + c) * 4096;
            const float blast = bbuf[63 * 256 + d];
            const int e = ch - 512, hv = e >> 7, dv = e & 127;
            const size_t vtile = (size_t)((b * 4 + hv) * 32 + c) * 8192;
            unsigned short xr[8], xn_[8];
#pragma unroll
            for (int u = 0; u < 8; ++u) xr[u] = Z[(size_t)(mbase + u) * NZ + ch];
#pragma unroll 1
            for (int t0 = 0; t0 < 64; t0 += 8) {
                if (t0 + 8 < 64) {
#pragma unroll
                    for (int u = 0; u < 8; ++u) xn_[u] = Z[(size_t)(mbase + t0 + 8 + u) * NZ + ch]; }
                float sv[8];
#pragma unroll
                for (int u = 0; u < 8; ++u) { const float x = bf2f(xr[u]); const float y = cw0 * x3 + cw1 * x2 + cw2 * x1 + cw3 * x; x3 = x2; x2 = x1; x1 = x; sv[u] = y * frcp(1.0f + __expf(-y)); }
                if (ch < 256) {
#pragma unroll
                    for (int u = 0; u < 8; ++u) { const float bt = bbuf[(t0 + u) * 256 + d]; QT[tile + (t0 + u) * 64 + dk] = (bf16)f2bf(sv[u] * 0.125f * __expf(bt)); } }
                else if (ch < 512) { v4u kd;
#pragma unroll
                    for (int u = 0; u < 8; ++u) { const float bt = bbuf[(t0 + u) * 256 + d]; KT[tile + (t0 + u) * 64 + dk] = (bf16)f2bf(sv[u] * __expf(-bt)); sv[u] = sv[u] * __expf(blast - bt); }
                    kd.x = pk2(sv[0], sv[1]); kd.y = pk2(sv[2], sv[3]); kd.z = pk2(sv[4], sv[5]); kd.w = pk2(sv[6], sv[7]);
                    *(v4u*)(KDT + tile + dk * 64 + t0) = kd; }
                else { v4u vv; vv.x = pk2(sv[0], sv[1]); vv.y = pk2(sv[2], sv[3]); vv.z = pk2(sv[4], sv[5]); vv.w = pk2(sv[6], sv[7]);
                    *(v4u*)(VT + vtile + dv * 64 + t0) = vv; }
#pragma unroll
                for (int u = 0; u < 8; ++u) xr[u] = xn_[u]; } }
        __syncthreads();
    }
}

__device__ __forceinline__ void rwkv_scan_naive(const Ptrs& P, LAS unsigned char* lds, int lane, int bh) {
    unsigned char* ws = P.ws;
    const bf16* Z = (const bf16*)(ws + WS_Z);
    const float* DEC = (const float*)((unsigned char*)P.out + DO_DEC);
    const bf16 *KF = (const bf16*)(ws + WS_KF), *KK = (const bf16*)(ws + WS_KK), *BB = (const bf16*)(ws + WS_BB), *GG = (const bf16*)(ws + WS_GG);
    const float* BON = (const float*)(ws + WS_BON);
    bf16* OCAT = (bf16*)(ws + WS_OCAT);
    const int b = bh >> 3, h = bh & 7, ch = h * 64 + lane;
    const float mur = P.in[I_MU][ch], muv = P.in[I_MU][1024 + ch], gnw = P.in[I_GNW][ch], gnb = P.in[I_GNB][ch];
    LAS float* vec = (LAS float*)lds;
    float s[64];
#pragma unroll
    for (int j = 0; j < 64; ++j) s[j] = 0.f;
    float zrp = 0.f, zvp = 0.f;
#pragma unroll 1
    for (int t0 = 0; t0 < SEQ; t0 += 16) {
#pragma unroll 4
        for (int tt = 0; tt < 16; ++tt) { const size_t m = (size_t)b * SEQ + t0 + tt;
            const float zr = bf2f(Z[m * NZ + ZRR + ch]), zv = bf2f(Z[m * NZ + ZRV + ch]);
            const float r = zr + mur * (zrp - zr), v = zv + muv * (zvp - zv); zrp = zr; zvp = zv;
            LAS float* vp = vec + tt * 384 + lane;
            vp[0] = DEC[m * 512 + ch]; vp[64] = -bf2f(KK[m * 512 + ch]); vp[128] = bf2f(BB[m * 512 + ch]); vp[192] = bf2f(KF[m * 512 + ch]); vp[256] = r; vp[320] = v; }
        LDS_WAIT(); asm volatile("" ::: "memory");
#pragma unroll 1
        for (int tt = 0; tt < 16; ++tt) { const size_t m = (size_t)b * SEQ + t0 + tt;
            const LAS float* vp = vec + tt * 384;
            const float v = vp[320 + lane];
            float sa = 0.f;
#pragma unroll
            for (int j = 0; j < 64; ++j) sa += s[j] * vp[64 + j];
            float y = 0.f;
#pragma unroll
            for (int j = 0; j < 64; ++j) { s[j] = s[j] * vp[j] + (sa * vp[128 + j] + v * vp[192 + j]); y += s[j] * vp[256 + j]; }
            const float mean = wave_sum(y) * (1.0f / 64.0f), dlt = y - mean;
            const float var = wave_sum(dlt * dlt) * (1.0f / 64.0f);
            float yn = dlt * (1.0f / sqrtf(var + 64e-5f)) * gnw + gnb;
            yn += BON[m * 8 + h] * v;
            OCAT[m * 1024 + 512 + ch] = (bf16)f2bf(yn * bf2f(GG[m * 512 + ch])); }
        LDS_WAIT(); asm volatile("" ::: "memory");
    }
}
__device__ __forceinline__ void gla_scan_naive(const Ptrs& P, int lane, int bh) {
    unsigned char* ws = P.ws;
    const bf16* Z = (const bf16*)(ws + WS_Z);
    const bf16 *QT = (const bf16*)((unsigned char*)P.out + DO_QT), *KT = (const bf16*)((unsigned char*)P.out + DO_KT), *VT = (const bf16*)(ws + WS_VT);
    const float* EL = (const float*)(ws + WS_EL);
    bf16* OCAT = (bf16*)(ws + WS_OCAT);
    const int b = bh >> 2, h = bh & 3;
    const float ng0 = P.in[I_NORMG][lane], ng1 = P.in[I_NORMG][64 + lane];
    float U0[64], U1[64];
#pragma unroll
    for (int d = 0; d < 64; ++d) { U0[d] = 0.f; U1[d] = 0.f; }
#pragma unroll 1
    for (int c = 0; c < 32; ++c) { const size_t tl = (size_t)(bh * 32 + c);
        const bf16 *qt = QT + tl * 4096, *kt = KT + tl * 4096, *vt = VT + tl * 8192;
#pragma unroll 1
        for (int t = 0; t < 64; ++t) { const size_t m = (size_t)b * SEQ + c * 64 + t;
            const float v0 = bf2f(vt[lane * 64 + t]), v1 = bf2f(vt[(64 + lane) * 64 + t]);
            float o0 = 0.f, o1 = 0.f;
#pragma unroll
            for (int d = 0; d < 64; ++d) { const float kd = bf2f(kt[t * 64 + d]), qd = bf2f(qt[t * 64 + d]);
                U0[d] += kd * v0; U1[d] += kd * v1; o0 += qd * U0[d]; o1 += qd * U1[d]; }
            const float rstd = 1.0f / sqrtf(wave_sum(o0 * o0 + o1 * o1) * (1.0f / 128.0f) + EPS);
            const float g0 = bf2f(Z[m * NZ + ZG + h * 128 + lane]), g1 = bf2f(Z[m * NZ + ZG + h * 128 + 64 + lane]);
            OCAT[m * 1024 + h * 128 + lane] = (bf16)f2bf(o0 * rstd * ng0 * (g0 / (1.0f + expf(-g0))));
            OCAT[m * 1024 + h * 128 + 64 + lane] = (bf16)f2bf(o1 * rstd * ng1 * (g1 / (1.0f + expf(-g1)))); }
        const float* el = EL + tl * 64;
#pragma unroll
        for (int d = 0; d < 64; ++d) { const float e = el[d]; U0[d] *= e; U1[d] *= e; } }
}


__device__ __forceinline__ float dpp_f(float x, const int ctrl_sel) {
    int r;
    const int xi = __float_as_int(x);
    switch (ctrl_sel) {
        case 0: r = __builtin_amdgcn_update_dpp(0, xi, 0xB1, 0xF, 0xF, true); break;
        case 1: r = __builtin_amdgcn_update_dpp(0, xi, 0x4E, 0xF, 0xF, true); break;
        case 2: r = __builtin_amdgcn_update_dpp(0, xi, 0x141, 0xF, 0xF, true); break;
        default: r = __builtin_amdgcn_update_dpp(0, xi, 0x140, 0xF, 0xF, true); break;
    }
    return __int_as_float(r);
}
__device__ __forceinline__ float allreduce16(float x) { x += dpp_f(x, 0); x += dpp_f(x, 1); x += dpp_f(x, 2); x += dpp_f(x, 3); return x; }
typedef float f32x2v __attribute__((ext_vector_type(2)));
__device__ __forceinline__ float afma(float a, float b, float c) { float d; asm("v_fma_f32 %0, %1, %2, %3" : "=v"(d) : "v"(a), "v"(b), "v"(c)); return d; }
__device__ __forceinline__ float amul(float a, float b) { float d; asm("v_mul_f32 %0, %1, %2" : "=v"(d) : "v"(a), "v"(b)); return d; }
__device__ __forceinline__ void allreduce16x2(float& a, float& b) {
    asm volatile("s_nop 1\n\t"
                 "v_add_f32_dpp %0, %0, %0 quad_perm:[1,0,3,2] row_mask:0xf bank_mask:0xf bound_ctrl:1\n\t"
                 "v_add_f32_dpp %1, %1, %1 quad_perm:[1,0,3,2] row_mask:0xf bank_mask:0xf bound_ctrl:1\n\t"
                 "s_nop 0\n\t"
                 "v_add_f32_dpp %0, %0, %0 quad_perm:[2,3,0,1] row_mask:0xf bank_mask:0xf bound_ctrl:1\n\t"
                 "v_add_f32_dpp %1, %1, %1 quad_perm:[2,3,0,1] row_mask:0xf bank_mask:0xf bound_ctrl:1\n\t"
                 "s_nop 0\n\t"
                 "v_add_f32_dpp %0, %0, %0 row_half_mirror row_mask:0xf bank_mask:0xf bound_ctrl:1\n\t"
                 "v_add_f32_dpp %1, %1, %1 row_half_mirror row_mask:0xf bank_mask:0xf bound_ctrl:1\n\t"
                 "s_nop 0\n\t"
                 "v_add_f32_dpp %0, %0, %0 row_mirror row_mask:0xf bank_mask:0xf bound_ctrl:1\n\t"
                 "v_add_f32_dpp %1, %1, %1 row_mirror row_mask:0xf bank_mask:0xf bound_ctrl:1"
                 : "+v"(a), "+v"(b));
}

__device__ __forceinline__ void rwkv_scan(const Ptrs& P, LAS unsigned char* lds, int tid, int lane, int wave, int bh) {
    using pg8::f32x4;
    constexpr int TC = 32, NCH = SEQ / TC;
    unsigned char* ws = P.ws;
    const bf16* Z = (const bf16*)(ws + WS_Z);
    const float* DEC = (const float*)((unsigned char*)P.out + DO_DEC);
    const bf16 *KF = (const bf16*)(ws + WS_KF), *KK = (const bf16*)(ws + WS_KK), *BB = (const bf16*)(ws + WS_BB), *GG = (const bf16*)(ws + WS_GG);
    const float* BON = (const float*)(ws + WS_BON);
    bf16* OCAT = (bf16*)(ws + WS_OCAT);
    LAS float* bufs = (LAS float*)lds;
    LAS float* ybuf = bufs + 2 * TC * 384;
    const int b = bh >> 3, h = bh & 7;
    const int st_t = tid >> 4, st_c = tid & 15, st_ch = h * 64 + 4 * st_c;
    const f32x4 mur4 = *(const f32x4*)(P.in[I_MU] + st_ch), muv4 = *(const f32x4*)(P.in[I_MU] + 1024 + st_ch);
    const int p = lane & 15, q = lane >> 4, i0 = wave * 8 + 2 * q;
    const int pch = h * 64 + lane;
    const float gnw = P.in[I_GNW][pch], gnb = P.in[I_GNB][pch];
    f32x4 s0 = {0.f, 0.f, 0.f, 0.f}, s1 = {0.f, 0.f, 0.f, 0.f};
    f32x4 g_dec; v2u g_kf, g_kk, g_bb, g_zr, g_zv, g_zrp, g_zvp; unsigned short g_gg[4]; float g_bon[4];
#define RW_LOAD(cidx) do { const size_t m_ = (size_t)b * SEQ + (size_t)(cidx) * TC + st_t; const size_t o_ = m_ * 512 + st_ch; \
        g_dec = *(const f32x4*)(DEC + o_); g_kf = *(const v2u*)(KF + o_); g_kk = *(const v2u*)(KK + o_); g_bb = *(const v2u*)(BB + o_); \
        g_zr = *(const v2u*)(Z + m_ * NZ + ZRR + st_ch); g_zv = *(const v2u*)(Z + m_ * NZ + ZRV + st_ch); \
        if (((cidx) * TC + st_t) == 0) { g_zrp = (v2u){0u, 0u}; g_zvp = (v2u){0u, 0u}; } \
        else { g_zrp = *(const v2u*)(Z + (m_ - 1) * NZ + ZRR + st_ch); g_zvp = *(const v2u*)(Z + (m_ - 1) * NZ + ZRV + st_ch); } } while (0)
#define RW_LOAD_POST(cidx) do { _Pragma("unroll") for (int k_ = 0; k_ < 4; ++k_) { const size_t m_ = (size_t)b * SEQ + (size_t)(cidx) * TC + wave * 4 + k_; \
        g_gg[k_] = GG[m_ * 512 + pch]; g_bon[k_] = BON[m_ * 8 + h]; } } while (0)
#define RW_WRITE(dst) do { LAS float* d_ = (dst) + st_t * 384 + 4 * st_c; \
        *(LAS f32x4*)(d_) = g_dec; \
        *(LAS f32x4*)(d_ + 64) = (f32x4){-pg8::bflo(g_kk.x), -pg8::bfhi(g_kk.x), -pg8::bflo(g_kk.y), -pg8::bfhi(g_kk.y)}; \
        *(LAS f32x4*)(d_ + 128) = (f32x4){pg8::bflo(g_bb.x), pg8::bfhi(g_bb.x), pg8::bflo(g_bb.y), pg8::bfhi(g_bb.y)}; \
        *(LAS f32x4*)(d_ + 192) = (f32x4){pg8::bflo(g_kf.x), pg8::bfhi(g_kf.x), pg8::bflo(g_kf.y), pg8::bfhi(g_kf.y)}; \
        { const f32x4 zr_ = {pg8::bflo(g_zr.x), pg8::bfhi(g_zr.x), pg8::bflo(g_zr.y), pg8::bfhi(g_zr.y)}, zp_ = {pg8::bflo(g_zrp.x), pg8::bfhi(g_zrp.x), pg8::bflo(g_zrp.y), pg8::bfhi(g_zrp.y)}; \
          *(LAS f32x4*)(d_ + 256) = zr_ + mur4 * (zp_ - zr_); } \
        { const f32x4 zv_ = {pg8::bflo(g_zv.x), pg8::bfhi(g_zv.x), pg8::bflo(g_zv.y), pg8::bfhi(g_zv.y)}, zp_ = {pg8::bflo(g_zvp.x), pg8::bfhi(g_zvp.x), pg8::bflo(g_zvp.y), pg8::bfhi(g_zvp.y)}; \
          *(LAS f32x4*)(d_ + 320) = zv_ + muv4 * (zp_ - zv_); } } while (0)
    RW_LOAD(0); RW_WRITE(bufs);
    __syncthreads();
#pragma unroll 1
    for (int c = 0; c < NCH; ++c) {
        LAS float* cur = bufs + (c & 1) * TC * 384; LAS float* nxt = bufs + ((c & 1) ^ 1) * TC * 384;
        if (c + 1 < NCH) RW_LOAD(c + 1);
        RW_LOAD_POST(c);
        {
            const LAS float* sp = cur + 4 * p; const LAS float* vp = cur + 320 + i0; LAS float* yp = ybuf + i0;
            f32x4 wA, aA, bA, kA, rA, wB, aB, bB, kB, rB; f32x2v vA, vB;
#define RW_LD(S, tt_) do { w##S = *(const LAS f32x4*)(sp + (tt_) * 384); a##S = *(const LAS f32x4*)(sp + (tt_) * 384 + 64); b##S = *(const LAS f32x4*)(sp + (tt_) * 384 + 128); \
                k##S = *(const LAS f32x4*)(sp + (tt_) * 384 + 192); r##S = *(const LAS f32x4*)(sp + (tt_) * 384 + 256); v##S = *(const LAS f32x2v*)(vp + (tt_) * 384); } while (0)
#define RW_STEP(S, tt_) do { \
                float sa0 = amul(s00, a##S[0]), sa1 = amul(s10, a##S[0]); \
                sa0 = afma(s01, a##S[1], sa0); sa1 = afma(s11, a##S[1], sa1); sa0 = afma(s02, a##S[2], sa0); sa1 = afma(s12, a##S[2], sa1); sa0 = afma(s03, a##S[3], sa0); sa1 = afma(s13, a##S[3], sa1); \
                const float c00 = amul(k##S[0], v##S.x), c01 = amul(k##S[1], v##S.x), c02 = amul(k##S[2], v##S.x), c03 = amul(k##S[3], v##S.x); \
                const float c10 = amul(k##S[0], v##S.y), c11 = amul(k##S[1], v##S.y), c12 = amul(k##S[2], v##S.y), c13 = amul(k##S[3], v##S.y); \
                allreduce16x2(sa0, sa1); \
                s00 = afma(s00, w##S[0], afma(b##S[0], sa0, c00)); s01 = afma(s01, w##S[1], afma(b##S[1], sa0, c01)); s02 = afma(s02, w##S[2], afma(b##S[2], sa0, c02)); s03 = afma(s03, w##S[3], afma(b##S[3], sa0, c03)); \
                s10 = afma(s10, w##S[0], afma(b##S[0], sa1, c10)); s11 = afma(s11, w##S[1], afma(b##S[1], sa1, c11)); s12 = afma(s12, w##S[2], afma(b##S[2], sa1, c12)); s13 = afma(s13, w##S[3], afma(b##S[3], sa1, c13)); \
                float y0 = amul(s00, r##S[0]), y1 = amul(s10, r##S[0]); \
                y0 = afma(s01, r##S[1], y0); y1 = afma(s11, r##S[1], y1); y0 = afma(s02, r##S[2], y0); y1 = afma(s12, r##S[2], y1); y0 = afma(s03, r##S[3], y0); y1 = afma(s13, r##S[3], y1); \
                allreduce16x2(y0, y1); \
                if (p == 0) *(LAS f32x2v*)(yp + (tt_) * 64) = (f32x2v){y0, y1}; } while (0)
            float s00 = s0[0], s01 = s0[1], s02 = s0[2], s03 = s0[3], s10 = s1[0], s11 = s1[1], s12 = s1[2], s13 = s1[3];
            RW_LD(A, 0);
#pragma unroll 2
            for (int tt = 0; tt < TC; tt += 2) {
                RW_LD(B, tt + 1);
                RW_STEP(A, tt);
                if (tt + 2 < TC) RW_LD(A, tt + 2);
                RW_STEP(B, tt + 1);
            }
            s0 = (f32x4){s00, s01, s02, s03}; s1 = (f32x4){s10, s11, s12, s13};
#undef RW_LD
#undef RW_STEP
        }
        __syncthreads();
#if (PROBE_DUP & 16)
#pragma unroll 1
        for (int rep_ = 0; rep_ < 2; ++rep_)
#endif
#pragma unroll
        for (int k_ = 0; k_ < 4; ++k_) { const int tt = wave * 4 + k_; const size_t m = (size_t)b * SEQ + (size_t)c * TC + tt;
            const float y = ybuf[tt * 64 + lane], v = cur[tt * 384 + 320 + lane];
            const float mean = wave_sum(y) * (1.0f / 64.0f), dl = y - mean;
            const float var = wave_sum(dl * dl) * (1.0f / 64.0f);
            float yn = dl * (1.0f / sqrtf(var + 64e-5f)) * gnw + gnb;
            yn += g_bon[k_] * v;
            OCAT[m * 1024 + 512 + pch] = (bf16)f2bf(yn * bf2f(g_gg[k_])); }
        if (c + 1 < NCH) RW_WRITE(nxt);
        __syncthreads();
    }
#undef RW_LOAD
#undef RW_LOAD_POST
#undef RW_WRITE
}


__device__ __forceinline__ void gla_scan(const Ptrs& P, LAS unsigned char* lds, int tid, int lane, int wave, int bh) {
    using pg8::bf16x8; using pg8::f32x4;
    constexpr int RS = 144, T64 = 64 * RS, T128 = 128 * RS;
    constexpr int OFF_QT = 0, OFF_KT = T64, OFF_KDT = 2 * T64, OFF_VT = 3 * T64, BUFSZ = 3 * T64 + T128;
    constexpr int OFF_P = 2 * BUFSZ, OFF_ST = OFF_P + 2 * T64, OFF_SS = OFF_ST + T128, OFF_GO = OFF_SS + 512, GOP = 272;
    static_assert(OFF_GO + 64 * GOP <= LDS_MISC, "gla LDS map");
    unsigned char* ws = P.ws;
    const bf16* Z = (const bf16*)(ws + WS_Z);
    const bf16 *QT = (const bf16*)((unsigned char*)P.out + DO_QT), *KT = (const bf16*)((unsigned char*)P.out + DO_KT), *KDT = (const bf16*)((unsigned char*)P.out + DO_KDT), *VT = (const bf16*)(ws + WS_VT);
    const float* EL = (const float*)(ws + WS_EL);
    bf16* OCAT = (bf16*)(ws + WS_OCAT);
    const int b = bh >> 2, h = bh & 3;
    const int fr = lane & 15, fq = lane >> 4, wr2 = wave >> 1, wc2 = wave & 1;
    const int st_row = tid >> 3, st_c = tid & 7;
    LAS float* SS = (LAS float*)(lds + OFF_SS);
    for (int i = tid; i < T128 / 16; i += 512) *(LAS v4u*)(lds + OFF_ST + i * 16) = (v4u){0u, 0u, 0u, 0u};
    float ng[4];
#pragma unroll
    for (int j = 0; j < 4; ++j) ng[j] = P.in[I_NORMG][(wc2 * 4 + j) * 16 + fr];
    f32x4 Sacc[4];
#pragma unroll
    for (int j = 0; j < 4; ++j) Sacc[j] = (f32x4){0.f, 0.f, 0.f, 0.f};
    v4u gA_q, gA_k, gA_kd, gA_v0, gA_v1, gB_q, gB_k, gB_kd, gB_v0, gB_v1; f32x4 elA, elB; unsigned short gzA[4][4], gzB[4][4];
#define GL_LOAD(S, cidx) do { const size_t tl_ = (size_t)(bh * 32 + (cidx)); const size_t o_ = tl_ * 4096 + st_row * 64 + st_c * 8; \
        g##S##_q = *(const v4u*)(QT + o_); g##S##_k = *(const v4u*)(KT + o_); g##S##_kd = *(const v4u*)(KDT + o_); \
        g##S##_v0 = *(const v4u*)(VT + tl_ * 8192 + st_row * 64 + st_c * 8); g##S##_v1 = *(const v4u*)(VT + tl_ * 8192 + (st_row + 64) * 64 + st_c * 8); } while (0)
#define GL_WRITE(S, bufoff) do { LAS unsigned char* d_ = lds + (bufoff) + st_row * RS + st_c * 16; \
        *(LAS v4u*)(d_ + OFF_QT) = g##S##_q; *(LAS v4u*)(d_ + OFF_KT) = g##S##_k; *(LAS v4u*)(d_ + OFF_KDT) = g##S##_kd; *(LAS v4u*)(d_ + OFF_VT) = g##S##_v0; *(LAS v4u*)(d_ + OFF_VT + 64 * RS) = g##S##_v1; } while (0)
#define GL_LOAD_AUX(S, cidx) do { const size_t tl_ = (size_t)(bh * 32 + (cidx)); const size_t mb_ = (size_t)b * SEQ + (size_t)(cidx) * 64; \
        el##S = *(const f32x4*)(EL + tl_ * 64 + wr2 * 16 + 4 * fq); \
        _Pragma("unroll") for (int j = 0; j < 4; ++j) _Pragma("unroll") for (int r = 0; r < 4; ++r) gz##S[j][r] = Z[(mb_ + wr2 * 16 + 4 * fq + r) * NZ + ZG + h * 128 + (wc2 * 4 + j) * 16 + fr]; } while (0)
#define FRAG(base, rblk, ks) (*(const LAS bf16x8*)((base) + ((rblk) * 16 + fr) * RS + ((ks) * 32 + fq * 8) * 2))
#define GL_S1(boff, pi) do { LAS unsigned char* bq_ = lds + (boff) + OFF_QT; LAS unsigned char* bk_ = lds + (boff) + OFF_KT; \
        const bf16x8 a0 = FRAG(bk_, wr2, 0), a1 = FRAG(bk_, wr2, 1); \
        _Pragma("unroll") for (int j = 0; j < 2; ++j) { const int tib = wc2 * 2 + j; f32x4 d = {0.f, 0.f, 0.f, 0.f}; \
            d = __builtin_amdgcn_mfma_f32_16x16x32_bf16(a0, FRAG(bq_, tib, 0), d, 0, 0, 0); d = __builtin_amdgcn_mfma_f32_16x16x32_bf16(a1, FRAG(bq_, tib, 1), d, 0, 0, 0); \
            const int ti = tib * 16 + fr, tj0 = wr2 * 16 + 4 * fq; \
            v2u w; w.x = pk2(ti >= tj0 ? d[0] : 0.f, ti >= tj0 + 1 ? d[1] : 0.f); w.y = pk2(ti >= tj0 + 2 ? d[2] : 0.f, ti >= tj0 + 3 ? d[3] : 0.f); \
            *(LAS v2u*)(lds + OFF_P + (pi) * T64 + ti * RS + tj0 * 2) = w; } } while (0)
    GL_LOAD(A, 0); GL_WRITE(A, 0); GL_LOAD(B, 1); GL_LOAD_AUX(A, 0);
    __syncthreads();
    GL_S1(0, 0);
    LDS_WAIT(); __syncthreads();
#define GL_ITER(c, LS, WS) do { \
        const int cur = ((c) & 1) * BUFSZ, nxt = (((c) & 1) ^ 1) * BUFSZ; \
        const size_t mbase = (size_t)b * SEQ + (size_t)(c) * 64; \
        if ((c) >= 1) { _Pragma("unroll") for (int q_ = 0; q_ < 2; ++q_) { const int id_ = tid + 512 * q_; const v4u o_ = *(const LAS v4u*)(lds + OFF_GO + (id_ >> 4) * GOP + (id_ & 15) * 16); \
            *(v4u*)(OCAT + (mbase - 64 + (id_ >> 4)) * 1024 + h * 128 + (id_ & 15) * 8) = o_; } } \
        if ((c) + 1 < 32) { GL_WRITE(WS, nxt); GL_LOAD_AUX(WS, (c) + 1); } \
        if ((c) + 2 < 32) GL_LOAD(LS, (c) + 2); \
        LAS unsigned char* bq = lds + cur + OFF_QT; LAS unsigned char* bk = lds + cur + OFF_KT; LAS unsigned char* bkd = lds + cur + OFF_KDT; LAS unsigned char* bv = lds + cur + OFF_VT; \
        f32x4 O[4]; \
        { const bf16x8 p0 = FRAG(lds + OFF_P + ((c) & 1) * T64, wr2, 0), p1 = FRAG(lds + OFF_P + ((c) & 1) * T64, wr2, 1), q0 = FRAG(bq, wr2, 0), q1 = FRAG(bq, wr2, 1); \
          _Pragma("unroll") for (int j = 0; j < 4; ++j) { const int ct = wc2 * 4 + j; f32x4 d = {0.f, 0.f, 0.f, 0.f}; \
            d = __builtin_amdgcn_mfma_f32_16x16x32_bf16(p0, FRAG(bv, ct, 0), d, 0, 0, 0); d = __builtin_amdgcn_mfma_f32_16x16x32_bf16(p1, FRAG(bv, ct, 1), d, 0, 0, 0); \
            d = __builtin_amdgcn_mfma_f32_16x16x32_bf16(q0, FRAG(lds + OFF_ST, ct, 0), d, 0, 0, 0); d = __builtin_amdgcn_mfma_f32_16x16x32_bf16(q1, FRAG(lds + OFF_ST, ct, 1), d, 0, 0, 0); \
            O[j] = d; } } \
        { const bf16x8 a0 = FRAG(bkd, wr2, 0), a1 = FRAG(bkd, wr2, 1); \
          _Pragma("unroll") for (int j = 0; j < 4; ++j) { const int ct = wc2 * 4 + j; f32x4 d = Sacc[j] * el##LS; \
            d = __builtin_amdgcn_mfma_f32_16x16x32_bf16(a0, FRAG(bv, ct, 0), d, 0, 0, 0); d = __builtin_amdgcn_mfma_f32_16x16x32_bf16(a1, FRAG(bv, ct, 1), d, 0, 0, 0); \
            Sacc[j] = d; } } \
        { f32x4 sq = {0.f, 0.f, 0.f, 0.f}; \
          _Pragma("unroll") for (int j = 0; j < 4; ++j) sq += O[j] * O[j]; \
          _Pragma("unroll") for (int r = 0; r < 4; ++r) { const float t = allreduce16(sq[r]); if (fr == 0) SS[(wr2 * 16 + 4 * fq + r) * 2 + wc2] = t; } } \
        LDS_WAIT(); __syncthreads(); \
        _Pragma("unroll") for (int j = 0; j < 4; ++j) { const int ct = wc2 * 4 + j; v2u w; w.x = pk2(Sacc[j][0], Sacc[j][1]); w.y = pk2(Sacc[j][2], Sacc[j][3]); \
            *(LAS v2u*)(lds + OFF_ST + (ct * 16 + fr) * RS + (wr2 * 16 + 4 * fq) * 2) = w; } \
        _Pragma("unroll") for (int r = 0; r < 4; ++r) { const int ti = wr2 * 16 + 4 * fq + r; const f32x2v s2 = *(const LAS f32x2v*)(SS + ti * 2); \
            const float rstd = frsq((s2.x + s2.y) * (1.0f / 128.0f) + EPS); \
            _Pragma("unroll") for (int j = 0; j < 4; ++j) { LAS bf16* gp_ = (LAS bf16*)(lds + OFF_GO + ti * GOP + ((wc2 * 4 + j) * 16 + fr) * 2); const float g = bf2f(gz##LS[j][r]); \
                *gp_ = (bf16)f2bf(O[j][r] * rstd * ng[j] * (g * frcp(1.0f + __expf(-g)))); } } \
        if ((c) + 1 < 32) GL_S1(nxt, ((c) + 1) & 1); \
        LDS_WAIT(); __syncthreads(); } while (0)
#pragma unroll 1
    for (int c = 0; c < 32; c += 2) { GL_ITER(c, A, B); GL_ITER(c + 1, B, A); }
    { const size_t mb_ = (size_t)b * SEQ + 31 * 64;
#pragma unroll
      for (int q_ = 0; q_ < 2; ++q_) { const int id_ = tid + 512 * q_; const v4u o_ = *(const LAS v4u*)(lds + OFF_GO + (id_ >> 4) * GOP + (id_ & 15) * 16);
          *(v4u*)(OCAT + (mb_ + (id_ >> 4)) * 1024 + h * 128 + (id_ & 15) * 8) = o_; } }
#undef GL_ITER
#undef GL_LOAD_AUX
#undef GL_S1
#undef GL_LOAD
#undef GL_WRITE
#undef FRAG
}


constexpr size_t WS_GG2 = 77 * MiB;
constexpr size_t WS_QH = 381 * MiB, WS_GT = 413 * MiB, WS_LT = 445 * MiB, WS_VTT = 477 * MiB;
constexpr size_t DO_PM = 0;
__device__ __forceinline__ float dpp_shr(float x, const int n) {
    int r; const int xi = __float_as_int(x);
    switch (n) { case 1: r = __builtin_amdgcn_update_dpp(0, xi, 0x111, 0xF, 0xF, true); break; case 2: r = __builtin_amdgcn_update_dpp(0, xi, 0x112, 0xF, 0xF, true); break;
                 case 4: r = __builtin_amdgcn_update_dpp(0, xi, 0x114, 0xF, 0xF, true); break; default: r = __builtin_amdgcn_update_dpp(0, xi, 0x118, 0xF, 0xF, true); break; }
    return __int_as_float(r);
}

template <int I, int CS> __device__ __forceinline__ void fs_chunk(float (&x)[64], const float xi, const LAS unsigned char* nrow, const pg8::f32x4 (&cur)[2]) {
    pg8::f32x4 nxt[2];
    if constexpr (CS + 2 < 16) {
#pragma unroll
        for (int q = 0; q < 2; ++q) nxt[q] = *(const LAS pg8::f32x4*)(nrow + (CS + 2 + q) * 16); }
#pragma unroll
    for (int q = 0; q < 2; ++q)
#pragma unroll
        for (int e = 0; e < 4; ++e) if (4 * (CS + q) + e > I) x[4 * (CS + q) + e] += xi * cur[q][e];
    constexpr int q0 = 4 * CS;
    asm volatile("" : "+v"(x[q0]), "+v"(x[q0 + 1]), "+v"(x[q0 + 2]), "+v"(x[q0 + 3]), "+v"(x[q0 + 4]), "+v"(x[q0 + 5]), "+v"(x[q0 + 6]), "+v"(x[q0 + 7]) :: "memory");
    if constexpr (CS + 2 < 16) fs_chunk<I, CS + 2>(x, xi, nrow, nxt);
}
template <int I> __device__ __forceinline__ void fs_all(float (&x)[64], const LAS unsigned char* nabi) {
    constexpr int FPB = 68 * 4, G0 = ((I + 1) / 4) & ~1;
    const LAS unsigned char* nrow = nabi + I * FPB;
    pg8::f32x4 cur[2];
#pragma unroll
    for (int q = 0; q < 2; ++q) cur[q] = *(const LAS pg8::f32x4*)(nrow + (G0 + q) * 16);
    fs_chunk<I, G0>(x, x[I], nrow, cur);
    if constexpr (I + 1 < 63) fs_all<I + 1>(x, nabi);
}
template <int PK> __device__ __forceinline__ void rwa(const Ptrs& P, LAS unsigned char* lds, int tid, int lane, int wave) {
    using pg8::bf16x8; using pg8::f32x4; using pg8::bflo; using pg8::bfhi;
    constexpr int RS = 144, T64 = 64 * RS, LP = 336, FP = 68 * 4;
    constexpr int O_L = 0;
    constexpr int O_AT = 0, O_BT = T64, O_KT = 2 * T64, O_RT = 3 * T64, O_KH = 4 * T64, O_BHT = 5 * T64;
    constexpr int O_NABI = 6 * T64;
    constexpr int O_NAK = O_NABI + 64 * FP;
    constexpr int O_NBRT = O_NAK + 64 * FP;
    constexpr int O_AHT = O_NBRT + T64;
    constexpr int O_WM = O_AHT + T64;
    constexpr int O_MISC = O_WM + T64;
    constexpr int O_TBB = O_MISC + 4 * 256 * 4;
    static_assert(O_TBB + 4 * 1280 <= 131072 && O_L + 64 * LP <= O_NABI, "rwa LDS map");
    unsigned char* ws = P.ws;
    const bf16* Z = (const bf16*)(ws + WS_Z);
    bf16 *GG = (bf16*)(ws + WS_GG2), *QH = (bf16*)(ws + WS_QH), *GT = (bf16*)(ws + WS_GT), *LT = (bf16*)(ws + WS_LT), *VTT = (bf16*)(ws + WS_VTT);
    float* PM = (float*)((unsigned char*)P.out + DO_PM); float* BON = (float*)(ws + WS_BON);
    const float* mu = P.in[I_MU];
    const bf16* LWT = (const bf16*)(ws + WS_LWT);
    const int fr = lane & 15, fq = lane >> 4;
    LAS float* SSQ = (LAS float*)(lds + O_MISC); LAS float* BONP = SSQ + 256; LAS float* TOT = BONP + 256; LAS float* GC = TOT + 256;
    const int h = blockIdx.x & 7;
    const int mt = wave & 3, tt0 = 2 * (wave >> 2);
    const int c4 = 64 * h + 16 * mt + 4 * fq;
    for (int item = blockIdx.x; item < NB * 32 * 8; item += gridDim.x) {
        asm volatile("" ::: "memory");
        bf16x8 wf[5];
#pragma unroll
        for (int ks = 0; ks < 5; ++ks) wf[ks] = *(const bf16x8*)(LWT + (size_t)(64 * h + 16 * mt + fr) * 160 + 32 * ks + 8 * fq);
        const f32x4 w0 = *(const f32x4*)(P.in[I_W0] + c4), a0 = *(const f32x4*)(P.in[I_A0] + c4), kkc = *(const f32x4*)(P.in[I_KK] + c4), kac = *(const f32x4*)(P.in[I_KA] + c4),
                    rkc = *(const f32x4*)(P.in[I_RK] + c4), mur = *(const f32x4*)(mu + c4), muk = *(const f32x4*)(mu + 512 + c4), muv = *(const f32x4*)(mu + 1024 + c4);
        const int bc = item >> 3, b = bc >> 5, c = bc & 31; const int m0 = b * SEQ + c * 64;
        const size_t it4 = (size_t)((b * 8 + h) * 32 + c) * 4096;
#pragma unroll
        for (int half = 0; half < 2; ++half) { unsigned zcs[5], zps[5];
#pragma unroll
            for (int j = 0; j < 5; ++j) { const int pidx = tid + 512 * (5 * half + j), tt = pidx / 80, i = 2 * (pidx - tt * 80), m = m0 + tt;
                if (PK & 4) { zcs[j] = 0x3f803f80u + (unsigned)m; zps[j] = 0x3f003f00u; } else {
                zcs[j] = *(const unsigned*)(Z + (size_t)m * NZ + ZLOW + i); zps[j] = ((m & (SEQ - 1)) == 0) ? 0u : *(const unsigned*)(Z + (size_t)(m - 1) * NZ + ZLOW + i); } }
#pragma unroll
            for (int j = 0; j < 5; ++j) { const int pidx = tid + 512 * (5 * half + j), tt = pidx / 80, i = 2 * (pidx - tt * 80);
                const unsigned zc = zcs[j], zp = zps[j];
                float x0 = bflo(zc) + mu[1536 + i] * (bflo(zp) - bflo(zc)), x1 = bfhi(zc) + mu[1537 + i] * (bfhi(zp) - bfhi(zc));
                if (i < 32) { x0 = fast_tanh(x0); x1 = fast_tanh(x1); } else if (i >= 64) { x0 = fast_sigmoid(x0); x1 = fast_sigmoid(x1); }
                *(LAS unsigned*)(lds + O_L + tt * LP + i * 2) = pk2(x0, x1); }
            asm volatile("" ::: "memory"); }
        __syncthreads();
        f32x4 e_r[2], e_k[2], e_v[2], e_lw[2], e_kk[2], e_as[2];
#pragma unroll
        for (int u = 0; u < 2; ++u) { const int tt = tt0 + u, t = 16 * tt + fr, m = m0 + t;
            bf16x8 bl[5];
#pragma unroll
            for (int ks = 0; ks < 5; ++ks) bl[ks] = *(const LAS bf16x8*)(lds + O_L + t * LP + (32 * ks + 8 * fq) * 2);
            const f32x4 z4 = {0.f, 0.f, 0.f, 0.f};
            const f32x4 Dw = __builtin_amdgcn_mfma_f32_16x16x32_bf16(wf[0], bl[0], z4, 0, 0, 0);
            const f32x4 Da = __builtin_amdgcn_mfma_f32_16x16x32_bf16(wf[1], bl[1], z4, 0, 0, 0);
            f32x4 Dg = __builtin_amdgcn_mfma_f32_16x16x32_bf16(wf[2], bl[2], z4, 0, 0, 0);
            Dg = __builtin_amdgcn_mfma_f32_16x16x32_bf16(wf[3], bl[3], Dg, 0, 0, 0);
            Dg = __builtin_amdgcn_mfma_f32_16x16x32_bf16(wf[4], bl[4], Dg, 0, 0, 0);
            v2u zr = {0x3f803f80u, 0x3f003f00u}, zk = zr, zv = zr;
            if (!(PK & 8)) { zr = *(const v2u*)(Z + (size_t)m * NZ + ZRR + c4); zk = *(const v2u*)(Z + (size_t)m * NZ + ZRK + c4); zv = *(const v2u*)(Z + (size_t)m * NZ + ZRV + c4); }
            v2u zrp = {0u, 0u}, zkp = {0u, 0u}, zvp = {0u, 0u};
            if ((m & (SEQ - 1)) != 0 && !(PK & 8)) { zrp = *(const v2u*)(Z + (size_t)(m - 1) * NZ + ZRR + c4); zkp = *(const v2u*)(Z + (size_t)(m - 1) * NZ + ZRK + c4); zvp = *(const v2u*)(Z + (size_t)(m - 1) * NZ + ZRV + c4); }
            const f32x4 zr4 = {bflo(zr.x), bfhi(zr.x), bflo(zr.y), bfhi(zr.y)}, zrp4 = {bflo(zrp.x), bfhi(zrp.x), bflo(zrp.y), bfhi(zrp.y)};
            const f32x4 zk4 = {bflo(zk.x), bfhi(zk.x), bflo(zk.y), bfhi(zk.y)}, zkp4 = {bflo(zkp.x), bfhi(zkp.x), bflo(zkp.y), bfhi(zkp.y)};
            const f32x4 zv4 = {bflo(zv.x), bfhi(zv.x), bflo(zv.y), bfhi(zv.y)}, zvp4 = {bflo(zvp.x), bfhi(zvp.x), bflo(zvp.y), bfhi(zvp.y)};
            const f32x4 r4 = zr4 + mur * (zrp4 - zr4), k4 = zk4 + muk * (zkp4 - zk4), v4 = zv4 + muv * (zvp4 - zv4);
            f32x4 lw, as;
#pragma unroll
            for (int e = 0; e < 4; ++e) { const float nw = -(w0[e] + Dw[e]);
                const float sp = fmaxf(nw, 0.f) + __logf(1.0f + __expf(-fabsf(nw)));
                lw[e] = -__expf(-sp - 0.5f);
                as[e] = fast_sigmoid(a0[e] + Da[e]); }
            const f32x4 kk = k4 * kkc, kf = k4 * (1.0f + (as - 1.0f) * kac);
            float ssq = (kk[0] * kk[0] + kk[1] * kk[1]) + (kk[2] * kk[2] + kk[3] * kk[3]);
            float bon; { const f32x4 tb_ = r4 * kf * rkc; bon = (tb_[0] + tb_[1]) + (tb_[2] + tb_[3]); }
            ssq += __shfl_xor(ssq, 16); ssq += __shfl_xor(ssq, 32); bon += __shfl_xor(bon, 16); bon += __shfl_xor(bon, 32);
            if (fq == 0) { SSQ[t * 4 + mt] = ssq; BONP[t * 4 + mt] = bon; }
            { v2u w; w.x = pk2(Dg[0], Dg[1]); w.y = pk2(Dg[2], Dg[3]); if (PK == 0 || P.ws == nullptr) *(v2u*)(GG + (size_t)m * 512 + c4) = w; }
            e_r[u] = r4; e_k[u] = kf; e_v[u] = v4; e_lw[u] = lw; e_kk[u] = kk; e_as[u] = as; }
        f32x4 cum[2];
#pragma unroll
        for (int u = 0; u < 2; ++u) { f32x4 x = e_lw[u];
#pragma unroll
            for (int e = 0; e < 4; ++e) { float y = x[e]; y += dpp_shr(y, 1); y += dpp_shr(y, 2); y += dpp_shr(y, 4); y += dpp_shr(y, 8); x[e] = y; }
            cum[u] = x;
            if (fr == 15) *(LAS f32x4*)(TOT + (tt0 + u) * 64 + 16 * mt + 4 * fq) = x; }
        __syncthreads();
        f32x4 c63;
        { const LAS float* tp = TOT + 16 * mt + 4 * fq; const f32x4 t0_ = *(const LAS f32x4*)(tp), t1_ = *(const LAS f32x4*)(tp + 64), t2_ = *(const LAS f32x4*)(tp + 128), t3_ = *(const LAS f32x4*)(tp + 192);
          c63 = (t0_ + t1_) + (t2_ + t3_);
          f32x4 off0 = {0.f, 0.f, 0.f, 0.f}; if (tt0 == 2) off0 = t0_ + t1_;
          cum[0] = cum[0] + off0; cum[1] = cum[1] + off0 + (tt0 == 2 ? t2_ : t0_); }
        if (tt0 == 0 && fr == 0) *(LAS f32x4*)(GC + 16 * mt + 4 * fq) = (f32x4){__expf(c63[0]), __expf(c63[1]), __expf(c63[2]), __expf(c63[3])};
#pragma unroll
        for (int u = 0; u < 2; ++u) { const int tt = tt0 + u, t = 16 * tt + fr, m = m0 + t; const int j4 = 16 * mt + 4 * fq;
            const f32x4 sq = *(const LAS f32x4*)(SSQ + t * 4), bp = *(const LAS f32x4*)(BONP + t * 4);
            const float inv = fminf(frsq((sq[0] + sq[1]) + (sq[2] + sq[3])), 1e12f);
            if (mt == 0 && fq == 0 && (PK == 0 || P.ws == nullptr)) BON[(size_t)m * 8 + h] = (bp[0] + bp[1]) + (bp[2] + bp[3]);
            const f32x4 kn = e_kk[u] * inv, av = -kn, bv = kn * e_as[u];
            f32x4 at, bt, kt, rt, kh, bh;
#pragma unroll
            for (int e = 0; e < 4; ++e) { const float cu = cum[u][e], ein = __expf(-cu), eg = __expf(cu), ee = __expf(c63[e] - cu);
                at[e] = av[e] * __expf(cu - e_lw[u][e]); bt[e] = bv[e] * ein; kt[e] = e_k[u][e] * ein; rt[e] = e_r[u][e] * eg; bh[e] = bv[e] * ee; kh[e] = e_k[u][e] * ee; }
            LAS unsigned char* tp = lds + t * RS + j4 * 2;
            { v2u w; w.x = pk2(at[0], at[1]); w.y = pk2(at[2], at[3]); *(LAS v2u*)(tp + O_AT) = w; }
            { v2u w; w.x = pk2(bt[0], bt[1]); w.y = pk2(bt[2], bt[3]); *(LAS v2u*)(tp + O_BT) = w; }
            { v2u w; w.x = pk2(kt[0], kt[1]); w.y = pk2(kt[2], kt[3]); *(LAS v2u*)(tp + O_KT) = w; }
            { v2u w; w.x = pk2(rt[0], rt[1]); w.y = pk2(rt[2], rt[3]); *(LAS v2u*)(tp + O_RT) = w; }
            { v2u w; w.x = pk2(kh[0], kh[1]); w.y = pk2(kh[2], kh[3]); *(LAS v2u*)(tp + O_KH) = w; }
#pragma unroll
            for (int e = 0; e < 4; ++e) { *(LAS bf16*)(lds + O_BHT + (j4 + e) * RS + t * 2) = (bf16)f2bf(bh[e]);
                if (PK == 0 || P.ws == nullptr) VTT[it4 + (size_t)(j4 + e) * 64 + t] = (bf16)f2bf(e_v[u][e]); } }
        __syncthreads();
        const int ib = wave >> 1, tb0 = 2 * (wave & 1);
        int fr3 = fr, fq3 = fq; asm volatile("" : "+v"(fr3), "+v"(fq3));
#define FRG(off, rblk, ks) (*(const LAS bf16x8*)(lds + (off) + ((rblk) * 16 + fr3) * RS + ((ks) * 32 + fq3 * 8) * 2))
        f32x4 nkr[2];
        { const bf16x8 b0 = FRG(O_BT, ib, 0), b1 = FRG(O_BT, ib, 1), k0 = FRG(O_KT, ib, 0), k1 = FRG(O_KT, ib, 1);
#pragma unroll
          for (int u = 0; u < 2; ++u) { const int tb = tb0 + u; const f32x4 z4 = {0.f, 0.f, 0.f, 0.f};
            const bf16x8 a0_ = FRG(O_AT, tb, 0), a1_ = FRG(O_AT, tb, 1), r0_ = FRG(O_RT, tb, 0), r1_ = FRG(O_RT, tb, 1);
            f32x4 dab = __builtin_amdgcn_mfma_f32_16x16x32_bf16(b0, a0_, z4, 0, 0, 0); dab = __builtin_amdgcn_mfma_f32_16x16x32_bf16(b1, a1_, dab, 0, 0, 0);
            f32x4 dak = __builtin_amdgcn_mfma_f32_16x16x32_bf16(k0, a0_, z4, 0, 0, 0); dak = __builtin_amdgcn_mfma_f32_16x16x32_bf16(k1, a1_, dak, 0, 0, 0);
            f32x4 dbr = __builtin_amdgcn_mfma_f32_16x16x32_bf16(b0, r0_, z4, 0, 0, 0); dbr = __builtin_amdgcn_mfma_f32_16x16x32_bf16(b1, r1_, dbr, 0, 0, 0);
            f32x4 dkr = __builtin_amdgcn_mfma_f32_16x16x32_bf16(k0, r0_, z4, 0, 0, 0); dkr = __builtin_amdgcn_mfma_f32_16x16x32_bf16(k1, r1_, dkr, 0, 0, 0);
            const int t = 16 * tb + fr3, i0_ = 16 * ib + 4 * fq3;
#pragma unroll
            for (int e = 0; e < 4; ++e) { const bool lt = (i0_ + e) < t, le = (i0_ + e) <= t; dab[e] = lt ? dab[e] : 0.f; dak[e] = lt ? dak[e] : 0.f; dbr[e] = le ? dbr[e] : 0.f; dkr[e] = le ? dkr[e] : 0.f; }
#pragma unroll
            for (int e = 0; e < 4; ++e) *(LAS float*)(lds + O_NABI + (i0_ + e) * FP + t * 4) = dab[e];
            *(LAS f32x4*)(lds + O_NAK + t * FP + i0_ * 4) = dak;
            { v2u w; w.x = pk2(dbr[0], dbr[1]); w.y = pk2(dbr[2], dbr[3]); *(LAS v2u*)(lds + O_NBRT + t * RS + i0_ * 2) = w; }
            nkr[u] = dkr; } }
        __syncthreads();
        if (!(PK & 2)) {
        if (wave < 4) { const int tb = wave, r = lane & 15;
            float x[16];
#pragma unroll
            for (int cI = 0; cI < 16; ++cI) x[cI] = (cI == r) ? 1.0f : 0.0f;
            const LAS unsigned char* nb_ = lds + O_NABI + (16 * tb) * FP + (16 * tb) * 4;
#pragma unroll
            for (int i = 0; i < 15; ++i) { const float xi = x[i];
#pragma unroll
                for (int g = (i + 1) / 4; g < 4; ++g) { const f32x4 n4 = *(const LAS f32x4*)(nb_ + i * FP + g * 16);
#pragma unroll
                    for (int e = 0; e < 4; ++e) if (4 * g + e > i) x[4 * g + e] += xi * n4[e]; } }
            if (lane < 16) {
#pragma unroll
                for (int g = 0; g < 4; ++g) *(LAS f32x4*)(lds + O_TBB + tb * 1280 + r * 80 + g * 16) = (f32x4){x[4 * g], x[4 * g + 1], x[4 * g + 2], x[4 * g + 3]}; } }
        __syncthreads();
        { f32x4 XT[4];
#pragma unroll
          for (int tb = 0; tb < 4; ++tb) { f32x4 R;
            if (wave < 4) {
#pragma unroll
                for (int e = 0; e < 4; ++e) R[e] = bf2f(*(const LAS bf16*)(lds + O_AT + (16 * tb + 4 * fq + e) * RS + (16 * wave + fr) * 2)); }
            else {
#pragma unroll
                for (int e = 0; e < 4; ++e) R[e] = *(const LAS float*)(lds + O_NAK + (16 * tb + 4 * fq + e) * FP + (16 * (wave - 4) + fr) * 4); }
#pragma unroll
            for (int tbp = 0; tbp < tb; ++tbp)
#pragma unroll
                for (int rho = 0; rho < 4; ++rho) { const float a_ = *(const LAS float*)(lds + O_NABI + (16 * tbp + 4 * fq + rho) * FP + (16 * tb + fr) * 4);
                    R = __builtin_amdgcn_mfma_f32_16x16x4f32(a_, XT[tbp][rho], R, 0, 0, 0); }
            f32x4 Xn = {0.f, 0.f, 0.f, 0.f};
#pragma unroll
            for (int rho = 0; rho < 4; ++rho) { const float a_ = *(const LAS float*)(lds + O_TBB + tb * 1280 + (4 * fq + rho) * 80 + fr * 4);
                Xn = __builtin_amdgcn_mfma_f32_16x16x4f32(a_, R[rho], Xn, 0, 0, 0); }
            XT[tb] = Xn;
            LAS unsigned char* dst = lds + (wave < 4 ? O_AHT : O_WM) + (16 * (wave & 3) + fr) * RS + (16 * tb + 4 * fq) * 2;
            { v2u w; w.x = pk2(Xn[0], Xn[1]); w.y = pk2(Xn[2], Xn[3]); *(LAS v2u*)dst = w; } } }
        }
        __syncthreads();
        { const int rb = wave >> 1, cb0 = 2 * (wave & 1);
          asm volatile("" : "+v"(fr3), "+v"(fq3));
          const bf16x8 ah0 = FRG(O_AHT, rb, 0), ah1 = FRG(O_AHT, rb, 1), wm0 = FRG(O_WM, rb, 0), wm1 = FRG(O_WM, rb, 1);
#pragma unroll
          for (int u = 0; u < 2; ++u) { const int cb = cb0 + u;
            const bf16x8 nb0 = FRG(O_NBRT, cb, 0), nb1 = FRG(O_NBRT, cb, 1), bh0 = FRG(O_BHT, cb, 0), bh1 = FRG(O_BHT, cb, 1);
            const int n_ = 16 * cb + fr3, m4 = 16 * rb + 4 * fq3;
            { const v2u rw = *(const LAS v2u*)(lds + O_RT + n_ * RS + m4 * 2); f32x4 d = {bflo(rw.x), bfhi(rw.x), bflo(rw.y), bfhi(rw.y)};
              d = __builtin_amdgcn_mfma_f32_16x16x32_bf16(ah0, nb0, d, 0, 0, 0); d = __builtin_amdgcn_mfma_f32_16x16x32_bf16(ah1, nb1, d, 0, 0, 0);
              v2u w; w.x = pk2(d[0], d[1]); w.y = pk2(d[2], d[3]);
              if (PK == 0 || P.ws == nullptr) *(v2u*)(QH + it4 + (size_t)n_ * 64 + 32 * (rb >> 1) + 8 * fq3 + 4 * (rb & 1)) = w; }
            { f32x4 d = nkr[u];
              d = __builtin_amdgcn_mfma_f32_16x16x32_bf16(wm0, nb0, d, 0, 0, 0); d = __builtin_amdgcn_mfma_f32_16x16x32_bf16(wm1, nb1, d, 0, 0, 0);
              v2u w; w.x = pk2(d[0], d[1]); w.y = pk2(d[2], d[3]); if (PK == 0 || P.ws == nullptr) *(v2u*)(GT + it4 + (size_t)n_ * 64 + m4) = w; }
            { f32x4 d = {0.f, 0.f, 0.f, 0.f};
              d = __builtin_amdgcn_mfma_f32_16x16x32_bf16(ah0, bh0, d, 0, 0, 0); d = __builtin_amdgcn_mfma_f32_16x16x32_bf16(ah1, bh1, d, 0, 0, 0);
              f32x4 hi, lo;
#pragma unroll
              for (int e = 0; e < 4; ++e) { float v = d[e]; if (m4 + e == n_) v += GC[n_]; const float vh = __uint_as_float(f2bf(v) << 16); hi[e] = vh; lo[e] = v - vh; }
              bf16* pmh = (bf16*)PM + 2 * it4; bf16* pml = pmh + 4096;
              const size_t o_ = (size_t)n_ * 64 + 32 * (rb >> 1) + 8 * fq3 + 4 * (rb & 1);
              { v2u w; w.x = pk2(hi[0], hi[1]); w.y = pk2(hi[2], hi[3]); if (PK == 0 || P.ws == nullptr) *(v2u*)(pmh + o_) = w; }
              { v2u w; w.x = pk2(lo[0], lo[1]); w.y = pk2(lo[2], lo[3]); if (PK == 0 || P.ws == nullptr) *(v2u*)(pml + o_) = w; } }
            { f32x4 d;
#pragma unroll
              for (int e = 0; e < 4; ++e) d[e] = bf2f(*(const LAS bf16*)(lds + O_KH + (m4 + e) * RS + n_ * 2));
              d = __builtin_amdgcn_mfma_f32_16x16x32_bf16(wm0, bh0, d, 0, 0, 0); d = __builtin_amdgcn_mfma_f32_16x16x32_bf16(wm1, bh1, d, 0, 0, 0);
              v2u w; w.x = pk2(d[0], d[1]); w.y = pk2(d[2], d[3]); if (PK == 0 || P.ws == nullptr) *(v2u*)(LT + it4 + (size_t)n_ * 64 + m4) = w; } } }
#undef FRG
        __syncthreads();
    }
}


__device__ __forceinline__ float wave_sum_fast(float x) {
    x = allreduce16(x);
    const float s0 = __int_as_float(__builtin_amdgcn_readlane(__float_as_int(x), 0)), s1 = __int_as_float(__builtin_amdgcn_readlane(__float_as_int(x), 16)),
                s2 = __int_as_float(__builtin_amdgcn_readlane(__float_as_int(x), 32)), s3 = __int_as_float(__builtin_amdgcn_readlane(__float_as_int(x), 48));
    return (s0 + s1) + (s2 + s3);
}
__device__ __forceinline__ void rwb_compute(LAS unsigned char* bb, LAS float* yb, pg8::f32x4 (&ST)[4], int nt, int fr, int fq) {
    using pg8::bf16x8; using pg8::f32x4;
    constexpr int RS = 144, T64 = 64 * RS, O_QH = 0, O_GT = T64, O_LT = 2 * T64, O_VT = 3 * T64, O_PH = 4 * T64, O_PL = 5 * T64, YP = 65;
#define FRG(base, rblk, ks) (*(const LAS bf16x8*)((base) + ((rblk) * 16 + fr) * RS + ((ks) * 32 + fq * 8) * 2))
    bf16x8 sh[2], sl[2];
#pragma unroll
    for (int s = 0; s < 2; ++s) { v4u wh, wl; unsigned* ph = (unsigned*)&wh; unsigned* pl = (unsigned*)&wl;
#pragma unroll
        for (int q = 0; q < 4; ++q) { const f32x4 v = ST[2 * s + (q >> 1)]; const float a = v[2 * (q & 1)], c = v[2 * (q & 1) + 1];
            const unsigned ha = f2bf(a), hc = f2bf(c); ph[q] = ha | (hc << 16);
            pl[q] = pk2(a - __uint_as_float(ha << 16), c - __uint_as_float(hc << 16)); }
        sh[s] = __builtin_bit_cast(bf16x8, wh); sl[s] = __builtin_bit_cast(bf16x8, wl); }
    const bf16x8 vt0 = FRG(bb + O_VT, nt, 0), vt1 = FRG(bb + O_VT, nt, 1);
#pragma unroll
    for (int tt = 0; tt < 4; ++tt) { f32x4 d = {0.f, 0.f, 0.f, 0.f};
        d = __builtin_amdgcn_mfma_f32_16x16x32_bf16(FRG(bb + O_QH, tt, 0), sh[0], d, 0, 0, 0);
        d = __builtin_amdgcn_mfma_f32_16x16x32_bf16(FRG(bb + O_QH, tt, 1), sh[1], d, 0, 0, 0);
        d = __builtin_amdgcn_mfma_f32_16x16x32_bf16(FRG(bb + O_GT, tt, 0), vt0, d, 0, 0, 0);
        d = __builtin_amdgcn_mfma_f32_16x16x32_bf16(FRG(bb + O_GT, tt, 1), vt1, d, 0, 0, 0);
#pragma unroll
        for (int e = 0; e < 4; ++e) yb[(16 * tt + 4 * fq + e) * YP + 16 * nt + fr] = d[e]; }
    f32x4 SN[4];
#pragma unroll
    for (int mt = 0; mt < 4; ++mt) { f32x4 d = {0.f, 0.f, 0.f, 0.f};
#pragma unroll
        for (int s = 0; s < 2; ++s) { const bf16x8 ph_ = FRG(bb + O_PH, mt, s), pl_ = FRG(bb + O_PL, mt, s);
            d = __builtin_amdgcn_mfma_f32_16x16x32_bf16(pl_, sh[s], d, 0, 0, 0);
            d = __builtin_amdgcn_mfma_f32_16x16x32_bf16(ph_, sl[s], d, 0, 0, 0);
            d = __builtin_amdgcn_mfma_f32_16x16x32_bf16(ph_, sh[s], d, 0, 0, 0); }
        d = __builtin_amdgcn_mfma_f32_16x16x32_bf16(FRG(bb + O_LT, mt, 0), vt0, d, 0, 0, 0);
        d = __builtin_amdgcn_mfma_f32_16x16x32_bf16(FRG(bb + O_LT, mt, 1), vt1, d, 0, 0, 0);
        SN[mt] = d; }
#pragma unroll
    for (int mt = 0; mt < 4; ++mt) ST[mt] = SN[mt];
#undef FRG
}
template <int PK> __device__ __forceinline__ void rwb(const Ptrs& P, LAS unsigned char* lds, int tid, int lane, int wave, int bh) {
    using pg8::bf16x8; using pg8::f32x4; using pg8::bflo; using pg8::bfhi;
    constexpr int RS = 144, T64 = 64 * RS, YP = 65;
    constexpr int O_QH = 0, O_GT = T64, O_LT = 2 * T64, O_VT = 3 * T64, O_PH = 4 * T64, O_PL = 5 * T64, BUFSZ = 6 * T64;
    constexpr int O_Y = 2 * BUFSZ;
    static_assert(O_Y + 2 * 64 * YP * 4 <= LDS_MISC, "rwb LDS map");
    unsigned char* ws = P.ws;
    const bf16 *GG = (const bf16*)(ws + WS_GG2), *QH = (const bf16*)(ws + WS_QH), *GT = (const bf16*)(ws + WS_GT), *LT = (const bf16*)(ws + WS_LT), *VTT = (const bf16*)(ws + WS_VTT);
    const bf16* PMB = (const bf16*)((unsigned char*)P.out + DO_PM); const float* BON = (const float*)(ws + WS_BON);
    bf16* OCAT = (bf16*)(ws + WS_OCAT);
    const int b = bh >> 3, h = bh & 7, fr = lane & 15, fq = lane >> 4;
    v4u gA_t[6], gB_t[6]; unsigned short pg_gg[16]; float pg_bon[16]; v4u pg_v[2];
#define RB_LOAD(S, cidx) do { const size_t it_ = (size_t)(bh * 32 + (cidx)) * 4096; const size_t o_ = it_ + (tid >> 3) * 64 + (tid & 7) * 8; \
        g##S##_t[0] = *(const v4u*)(QH + o_); g##S##_t[1] = *(const v4u*)(GT + o_); g##S##_t[2] = *(const v4u*)(LT + o_); g##S##_t[3] = *(const v4u*)(VTT + o_); \
        g##S##_t[4] = *(const v4u*)(PMB + it_ + o_); g##S##_t[5] = *(const v4u*)(PMB + it_ + 4096 + o_); } while (0)
#define RB_WRITE(S, bufoff) do { LAS unsigned char* d_ = lds + (bufoff) + (tid >> 3) * RS + (tid & 7) * 16; \
        *(LAS v4u*)(d_ + O_QH) = g##S##_t[0]; *(LAS v4u*)(d_ + O_GT) = g##S##_t[1]; *(LAS v4u*)(d_ + O_LT) = g##S##_t[2]; *(LAS v4u*)(d_ + O_VT) = g##S##_t[3]; \
        *(LAS v4u*)(d_ + O_PH) = g##S##_t[4]; *(LAS v4u*)(d_ + O_PL) = g##S##_t[5]; } while (0)
    f32x4 ST[4];
#pragma unroll
    for (int j = 0; j < 4; ++j) ST[j] = (f32x4){0.f, 0.f, 0.f, 0.f};
    const int pch = h * 64 + lane;
    float gnw = 0.f, gnb = 0.f;
    if (wave >= 4) { gnw = P.in[I_GNW][pch]; gnb = P.in[I_GNB][pch]; }
    RB_LOAD(A, 0); RB_WRITE(A, 0); RB_LOAD(B, 1);
    __syncthreads();
#define RB_ITER(c, LS, WS) do { \
        const int cur = ((c) & 1) * BUFSZ, nxt = (((c) & 1) ^ 1) * BUFSZ; \
        if (!(PK & 4)) { if ((c) + 1 < 32) RB_WRITE(WS, nxt); if ((c) + 2 < 32) RB_LOAD(LS, (c) + 2); } \
        if (wave < 4) { if ((c) < 32 && !(PK & 2)) rwb_compute(lds + cur, (LAS float*)(lds + O_Y + ((c) & 1) * 64 * YP * 4), ST, wave, fr, fq); } \
        else { \
            if ((c) >= 1 && !(PK & 1)) { LAS float* yb = (LAS float*)(lds + O_Y + (((c) - 1) & 1) * 64 * YP * 4); const int w4 = wave - 4; \
                float s_ = 0.f, q_ = 0.f; { const LAS float* yr = yb + (w4 * 16 + fr) * YP + 16 * fq; \
                    _Pragma("unroll") for (int i_ = 0; i_ < 16; ++i_) { const float y_ = yr[i_]; s_ += y_; q_ += y_ * y_; } } \
                s_ += __shfl_xor(s_, 16); s_ += __shfl_xor(s_, 32); q_ += __shfl_xor(q_, 16); q_ += __shfl_xor(q_, 32); \
                const float mean_l = s_ * (1.0f / 64.0f); const float rstd_l = frsq(fmaxf(q_ * (1.0f / 64.0f) - mean_l * mean_l, 0.f) + 64e-5f);     \
                _Pragma("unroll") for (int k_ = 0; k_ < 16; ++k_) { const int t = w4 * 16 + k_; \
                    const float mean = __int_as_float(__builtin_amdgcn_readlane(__float_as_int(mean_l), k_)), rstd = __int_as_float(__builtin_amdgcn_readlane(__float_as_int(rstd_l), k_)); \
                    const unsigned vw_ = pg_v[k_ >> 3][(k_ >> 1) & 3]; const float v = (k_ & 1) ? bfhi(vw_) : bflo(vw_); const float y = yb[t * YP + lane]; \
                    float yn = (y - mean) * rstd * gnw + gnb; yn += pg_bon[k_] * v; \
                    *(LAS bf16*)((LAS unsigned char*)yb + t * (YP * 4) + lane * 2) = (bf16)f2bf(yn * bf2f(pg_gg[k_])); } \
                LDS_WAIT(); asm volatile("" ::: "memory"); \
                  \
                _Pragma("unroll") for (int q2 = 0; q2 < 2; ++q2) { const int id_ = lane + 64 * q2, r_ = id_ >> 3, p_ = id_ & 7; const int t = w4 * 16 + r_; \
                    const unsigned* op_ = (const unsigned*)0; (void)op_; const LAS unsigned* ow_ = (const LAS unsigned*)((const LAS unsigned char*)yb + t * (YP * 4) + p_ * 16); const v4u o_ = {ow_[0], ow_[1], ow_[2], ow_[3]}; \
                    if (PK == 0 || P.ws == nullptr) *(v4u*)(OCAT + ((size_t)b * SEQ + (size_t)((c) - 1) * 64 + t) * 1024 + 512 + h * 64 + p_ * 8) = o_; } } \
            if ((c) < 32) { const size_t itv_ = (size_t)(bh * 32 + (c)) * 4096 + (size_t)lane * 64 + (wave - 4) * 16; pg_v[0] = *(const v4u*)(VTT + itv_); pg_v[1] = *(const v4u*)(VTT + itv_ + 8); \
                _Pragma("unroll") for (int k_ = 0; k_ < 16; ++k_) { const size_t m = (size_t)b * SEQ + (size_t)(c) * 64 + (wave - 4) * 16 + k_; pg_gg[k_] = GG[m * 512 + pch]; pg_bon[k_] = BON[m * 8 + h]; } } } \
        LDS_WAIT(); __syncthreads(); } while (0)
#pragma unroll 1
    for (int c = 0; c <= 32; c += 2) { RB_ITER(c, A, B); if (c + 1 <= 32) RB_ITER(c + 1, B, A); }
#undef RB_ITER
#undef RB_LOAD
#undef RB_WRITE
}

#define XB_TMO      128
#define XB_XCNT(j)  (256  + 64 * (j))
#define XB_XSUB(j)  (1280 + 64 * (j))
#define XB_XGEN(j)  (2304 + 64 * (j))
#define XB_TOP      3328
#define XB_TOPGEN   3392
#define XCD_BAR_WORDS 3456
#define XB_SPIN_CAP (1u << 18)

__device__ __forceinline__ unsigned xb_ld(unsigned* p)              { return __hip_atomic_load(p, __ATOMIC_RELAXED, __HIP_MEMORY_SCOPE_AGENT); }
__device__ __forceinline__ unsigned xb_add(unsigned* p, unsigned v) { return __hip_atomic_fetch_add(p, v, __ATOMIC_RELAXED, __HIP_MEMORY_SCOPE_AGENT); }
__device__ __forceinline__ unsigned xb_xcc_id() { return (unsigned)__builtin_amdgcn_s_getreg((3 << 11) | 20) & 0xFu; }
#define XB_SPIN(cond, bar) do { unsigned _sp = 0; while (cond) { __builtin_amdgcn_s_sleep(1); \
    if ((++_sp & 255u) == 0u) { if (xb_ld(&(bar)[XB_TMO])) break; if (_sp > XB_SPIN_CAP) { atomicAdd(&(bar)[XB_TMO], 1u); break; } } } } while (0)

struct XcdBarrier {
    unsigned* bar; unsigned x;
    volatile LAS unsigned* st;
};

__device__ __forceinline__ XcdBarrier xcd_barrier_post(unsigned* bar, volatile LAS unsigned* st) {
    XcdBarrier b; b.bar = bar; b.x = xb_xcc_id(); b.st = st;
    if (threadIdx.x == 0) (void)xb_add(&bar[XB_XCNT(b.x)], 1u);
    return b;
}
__device__ __forceinline__ void xcd_barrier_complete(unsigned* bar, unsigned x, unsigned& nloc, unsigned& nx) {
    const unsigned G = gridDim.x * gridDim.y * gridDim.z;
    unsigned sum, cnt, mine, sp = 0u;
    for (;;) {
        sum = 0u; cnt = 0u; mine = 0u;
#pragma unroll
        for (unsigned j = 0; j < 16; ++j) { const unsigned c = xb_ld(&bar[XB_XCNT(j)]); sum += c; cnt += (c > 0u) ? 1u : 0u; mine = (j == x) ? c : mine; }
        if (sum == G) break;
        __builtin_amdgcn_s_sleep(1);
        if ((++sp & 255u) == 0u) { if (xb_ld(&bar[XB_TMO])) break; if (sp > XB_SPIN_CAP) { atomicAdd(&bar[XB_TMO], 1u); break; } }
    }
    nloc = mine > 0u ? mine : 1u; nx = cnt > 0u ? cnt : 1u;
}

__device__ __forceinline__ void xcd_barrier(const XcdBarrier& b) {
    asm volatile("s_waitcnt vmcnt(0)" ::: "memory");
    __syncthreads();
    if (threadIdx.x == 0) {
        unsigned* bar = b.bar;
        __builtin_amdgcn_s_waitcnt(0);
        unsigned nloc = b.st[0], nx = b.st[1];
        if (nloc == 0u) { xcd_barrier_complete(bar, b.x, nloc, nx); b.st[0] = nloc; b.st[1] = nx; }
        const unsigned old = xb_add(&bar[XB_XSUB(b.x)], 1u);
        const unsigned gen = old / nloc;
        if (old + 1u == (gen + 1u) * nloc) {
            __builtin_amdgcn_fence(__ATOMIC_RELEASE, "agent");
            asm volatile("s_waitcnt vmcnt(0)" ::: "memory");
            const unsigned og = xb_add(&bar[XB_TOP], 1u);
            const unsigned tg = og / nx;
            if (og + 1u == (tg + 1u) * nx) xb_add(&bar[XB_TOPGEN], 1u);
            else XB_SPIN(xb_ld(&bar[XB_TOPGEN]) == tg, bar);
            __builtin_amdgcn_fence(__ATOMIC_ACQUIRE, "agent");
            xb_add(&bar[XB_XGEN(b.x)], 1u);
            asm volatile("s_waitcnt vmcnt(0)" ::: "memory");
        } else {
            XB_SPIN(xb_ld(&bar[XB_XGEN(b.x)]) == gen, bar);
            __builtin_amdgcn_fence(__ATOMIC_ACQUIRE, "agent");
            asm volatile("s_waitcnt vmcnt(0)" ::: "memory");
        }
    }
    __syncthreads();
}

struct Args { const float* in[27]; float* out; unsigned char* ws; int ph_lo, ph_hi; };
constexpr int NPHASE = 9;
__global__ void __launch_bounds__(512, 2) mega(Args args) {
    extern __shared__ __attribute__((aligned(16))) unsigned char lds_raw[];
    LAS unsigned char* lds = (LAS unsigned char*)lds_raw;
    const int tid = threadIdx.x, lane = tid & 63, wave = __builtin_amdgcn_readfirstlane(tid >> 6);
    Ptrs P;
#pragma unroll
    for (int i = 0; i < 27; ++i) P.in[i] = args.in[i];
    P.out = args.out; P.ws = args.ws;
    unsigned char* ws = args.ws;
    const int lo = args.ph_lo, hi = args.ph_hi, G = gridDim.x, bx = blockIdx.x;
#define IN(k) (lo <= (k) && (k) < hi)
#define SEAM(k) do { if (IN(k) && IN((k) + 1)) xcd_barrier(bar); } while (0)
    float* SS2 = (float*)(ws + WS_SS); float* SS3 = SS2 + M; float* SS4 = SS3 + M;
    XcdBarrier bar; bar.bar = (unsigned*)(ws + WS_BAR); bar.x = 0; bar.st = (volatile LAS unsigned*)(lds + LDS_MISC);
    if (hi - lo > 1) { if (tid < 2) ((volatile LAS unsigned*)(lds + LDS_MISC))[tid] = 0u; __syncthreads(); bar = xcd_barrier_post((unsigned*)(ws + WS_BAR), (volatile LAS unsigned*)(lds + LDS_MISC)); }
    bf16* ABUF = (bf16*)(ws + WS_ABUF);

    if (IN(0)) { p0_prologue(P, lds, tid, lane, wave); } SEAM(0);
    if (IN(1)) {
      {
        pg8::Gemm g{ABUF, (const bf16*)(ws + WS_WIN), M, NZ, D}; pg8::StaticOrder S; S.init(M, NZ, G, bx);
        pg8::EpiStoreBf16 E{(bf16*)(ws + WS_Z), NZ};
        pg8::gemm_phase<pg8::EpiStoreBf16, pg8::StaticOrder, true, true>(lds, g, S, E); }
    } SEAM(1);
    if (IN(2)) {
        gla_pre2(P, lds, tid, lane, wave);
#if (PROBE_DUP & 16384)
        __syncthreads(); for (int i_ = tid; i_ < 131072 / 16; i_ += 512) *(LAS v4u*)(lds + i_ * 16) = (v4u){0xFFFFFFFFu, 0xFFFFFFFFu, 0xFFFFFFFFu, 0xFFFFFFFFu}; __syncthreads();
#endif
#if (PROBE_DUP & 1024)
        rwa<PROBE_RWA>(P, lds, tid, lane, wave);
#endif
        rwa<0>(P, lds, tid, lane, wave);
#if (PROBE_DUP & 1)
        rwa<PROBE_RWA>(P, lds, tid, lane, wave);
#endif
#if (PROBE_DUP & 2048)
        __syncthreads(); for (int i_ = tid; i_ < 131072 / 16; i_ += 512) *(LAS v4u*)(lds + i_ * 16) = (v4u){0xFFFFFFFFu, 0xFFFFFFFFu, 0xFFFFFFFFu, 0xFFFFFFFFu}; __syncthreads();
#endif
#if (PROBE_DUP & 512)
        if (bx & 1) { for (int i_ = 0; i_ < 100; ++i_) __builtin_amdgcn_s_sleep(127); }
#endif
#if (PROBE_DUP & 1)
        rwkv_pre2(P, lds, tid, lane, wave);
#endif
#if (PROBE_DUP & 2)
        gla_pre2(P, lds, tid, lane, wave);
#endif
    } SEAM(2);
    if (IN(3)) {
        if (bx < 128) rwb<0>(P, lds, tid, lane, wave, bx); else if (bx < 192) gla_scan(P, lds, tid, lane, wave, bx - 128);
        else p0_late_weights(P, lds, tid, lane, wave, bx - 192, G - 192);
#if (PROBE_DUP & 4)
        __syncthreads();
        if (bx < 128) rwb<PROBE_RWB>(P, lds, tid, lane, wave, bx);
#endif
#if (PROBE_DUP & 8)
        __syncthreads();
        if (bx >= 128 && bx < 192) gla_scan(P, lds, tid, lane, wave, bx - 128);
#endif
    } SEAM(3);
    if (IN(4)) {
        { pg8::Gemm g{(const bf16*)(ws + WS_OCAT), (const bf16*)(ws + WS_WOUT), M, D, D}; pg8::StaticOrder S; S.init(M, D, G, bx);
          pg8::EpiRes<false> E{P.in[I_X], nullptr, nullptr, ABUF, P.in[I_LNMLP], SS2};
          pg8::gemm_phase<pg8::EpiRes<false>, pg8::StaticOrder, true, true>(lds, g, S, E); }
        { pg8::Gemm g{(const bf16*)(ws + WS_PB), (const bf16*)(ws + WS_WP), M, D, PLE}; pg8::StaticOrder S; S.init(M, D, G, bx);
          pg8::EpiStoreBf16 E{(bf16*)(ws + WS_PP), D};
          pg8::gemm_phase<pg8::EpiStoreBf16, pg8::StaticOrder, true, true>(lds, g, S, E);
#if (PROBE_DUP & 4096)
          pg8::gemm_phase<pg8::EpiStoreBf16, pg8::StaticOrder, true, true>(lds, g, S, E);
#endif
        }
#if (PROBE_DUP & 8192)
        { pg8::Gemm g{(const bf16*)(ws + WS_OCAT), (const bf16*)(ws + WS_WOUT), M, D, D}; pg8::StaticOrder S; S.init(M, D, G, bx);
          pg8::EpiStoreBf16 E{(bf16*)(ws + WS_PP), D};
          pg8::gemm_phase<pg8::EpiStoreBf16, pg8::StaticOrder, true, true>(lds, g, S, E); }
        { pg8::Gemm g{(const bf16*)(ws + WS_PB), (const bf16*)(ws + WS_WP), M, D, PLE}; pg8::StaticOrder S; S.init(M, D, G, bx);
          pg8::EpiStoreBf16 E{(bf16*)(ws + WS_PP), D};
          pg8::gemm_phase<pg8::EpiStoreBf16, pg8::StaticOrder, true, true>(lds, g, S, E); }
#endif
    } SEAM(4);
    if (IN(5)) {
      {
        pg8::Gemm g{ABUF, (const bf16*)(ws + WS_W1), M, FF, D}; pg8::StaticOrder S; S.init(M, FF, G, bx);
        pg8::EpiFF1 E{(bf16*)(ws + WS_HFF), FF, SS2, EPS};
        pg8::gemm_phase<pg8::EpiFF1, pg8::StaticOrder, true, true>(lds, g, S, E);
#if (PROBE_DUP & 128)
        pg8::gemm_phase<pg8::EpiFF1, pg8::StaticOrder, true, true>(lds, g, S, E);
#endif
        }
    } SEAM(5);
#if (PROBE_DUP & 32768)
    if (IN(6)) { pg8::Gemm g{(const bf16*)(ws + WS_HFF), (const bf16*)(ws + WS_W2), M, D, FF}; pg8::StaticOrder S; S.init(M, D, G, bx);
        pg8::EpiStoreBf16 E{(bf16*)(ws + WS_LT), D};
        pg8::gemm_phase<pg8::EpiStoreBf16, pg8::StaticOrder, true, true>(lds, g, S, E); }
#endif
#if (PROBE_DUP & 65536)
    if (IN(6)) { for (int r_ = 0; r_ < 8; ++r_) xcd_barrier(bar); }
#endif
#if (PROBE_DUP & 131072)
    if (IN(7)) { pg8::Gemm g{ABUF, (const bf16*)(ws + WS_WG), M, D, D}; pg8::StaticOrder S; S.init(M, D, G, bx);
        pg8::EpiStoreBf16 E{(bf16*)(ws + WS_LT), D};
        pg8::gemm_phase<pg8::EpiStoreBf16, pg8::StaticOrder, true, true>(lds, g, S, E); }
#endif
    if (IN(6)) {
        pg8::Gemm g{(const bf16*)(ws + WS_HFF), (const bf16*)(ws + WS_W2), M, D, FF}; pg8::StaticOrder S; S.init(M, D, G, bx);
        pg8::EpiRes<true> E{nullptr, ABUF, P.in[I_LNMLP], ABUF, P.in[I_LNPLE], SS3};
        pg8::gemm_phase<pg8::EpiRes<true>, pg8::StaticOrder, true, true>(lds, g, S, E);
    } SEAM(6);
    if (IN(7)) {
        pg8::Gemm g{ABUF, (const bf16*)(ws + WS_WG), M, D, D}; pg8::StaticOrder S; S.init(M, D, G, bx);
        pg8::EpiGate E{ABUF, P.in[I_LNPLE], (const bf16*)(ws + WS_PP), P.out, SS3, SS4, EPS};
        pg8::gemm_phase<pg8::EpiGate, pg8::StaticOrder, true, true>(lds, g, S, E);
    } SEAM(7);
#if (PROBE_DUP & 262144)
    if (IN(8)) { float* scr_ = (float*)(ws + WS_Z);
        for (int m = bx * 8 + wave; m < M; m += G * 8) { const float rs = 1.0f / sqrtf(SS4[m] * (1.0f / D) + EPS);
            const pg8::f32x4* irow = (const pg8::f32x4*)(P.out + (size_t)m * D) + lane; pg8::f32x4* orow = (pg8::f32x4*)(scr_ + (size_t)m * D) + lane;
#pragma unroll
            for (int j = 0; j < 4; ++j) orow[64 * j] = irow[64 * j] * rs; } }
#endif
    if (IN(8)) {
        const float* gf = P.in[I_LNFIN]; pg8::f32x4 gv[4];
#pragma unroll
        for (int j = 0; j < 4; ++j) gv[j] = *((const pg8::f32x4*)gf + lane + 64 * j);
        pg8::f32x4 v[4], vn[4]; float ssn = 0.f, ssc = 0.f;
        { const int m = bx * 8 + wave; if (m < M) { ssc = SS4[m]; const pg8::f32x4* orow = (const pg8::f32x4*)(P.out + (size_t)m * D) + lane;
#pragma unroll
            for (int j = 0; j < 4; ++j) v[j] = orow[64 * j]; } }
        for (int m = bx * 8 + wave; m < M; m += G * 8) {
            const int mn = m + G * 8;
            if (mn < M) { ssn = SS4[mn]; const pg8::f32x4* orow = (const pg8::f32x4*)(P.out + (size_t)mn * D) + lane;
#pragma unroll
                for (int j = 0; j < 4; ++j) vn[j] = orow[64 * j]; }
            const float rs = frsq(ssc * (1.0f / D) + EPS);
            pg8::f32x4* orow = (pg8::f32x4*)(P.out + (size_t)m * D) + lane;
#pragma unroll
            for (int j = 0; j < 4; ++j) orow[64 * j] = v[j] * rs * gv[j];
#pragma unroll
            for (int j = 0; j < 4; ++j) v[j] = vn[j];
            ssc = ssn;
        }
    }
#undef IN
#undef SEAM
}

#ifndef MK_ONE_LAUNCH
#define MK_ONE_LAUNCH 1
#endif
extern "C" void kernel_launch(void* const* d_in, const int* in_sizes, int n_in, void* d_out, int out_size, void* d_ws, size_t ws_size, hipStream_t stream) {
    static int grid = 0;
    if (grid == 0) {
        if (n_in != 27 || in_sizes[0] != M * D || out_size != M * D || ws_size < WS_END) { fprintf(stderr, "kernel_launch: unexpected shapes (n_in %d in0 %d out %d ws %zu)\n", n_in, n_in > 0 ? in_sizes[0] : -1, out_size, ws_size); grid = -1; return; }
        int dev = 0, cus = 0, per_cu = 0;
        (void)hipGetDevice(&dev); (void)hipDeviceGetAttribute(&cus, hipDeviceAttributeMultiprocessorCount, dev);
        if (hipFuncSetAttribute((const void*)mega, hipFuncAttributeMaxDynamicSharedMemorySize, LDS_BYTES) != hipSuccess) { fprintf(stderr, "kernel_launch: hipFuncSetAttribute failed\n"); grid = -1; return; }
        (void)hipOccupancyMaxActiveBlocksPerMultiprocessor(&per_cu, (const void*)mega, 512, LDS_BYTES);
        if (per_cu < 1) { fprintf(stderr, "kernel_launch: occupancy query says %d blocks per CU\n", per_cu); }
        (void)hipGetLastError();
        grid = cus;
    }
    if (grid < 0) return;
    Args a{};
    for (int i = 0; i < 27; ++i) a.in[i] = (const float*)d_in[i];
    a.out = (float*)d_out; a.ws = (unsigned char*)d_ws;
#if MK_ONE_LAUNCH
    a.ph_lo = 0; a.ph_hi = NPHASE;
    if (hipMemsetAsync((unsigned char*)d_ws + WS_BAR, 0, XCD_BAR_WORDS * 4, stream) != hipSuccess) { fprintf(stderr, "kernel_launch: memset of the barrier words failed\n"); return; }
    hipLaunchKernelGGL(mega, dim3(grid), dim3(512), LDS_BYTES, stream, a);
#else
    for (int ph = 0; ph < NPHASE; ++ph) { a.ph_lo = ph; a.ph_hi = ph + 1; hipLaunchKernelGGL(mega, dim3(grid), dim3(512), LDS_BYTES, stream, a); }
#endif
}
```
